# Optimizing an MI355X kernel written in HIP

```python
import math
import jax
import jax.numpy as jnp
from jax import lax
import numpy as np

D_MODEL = 1024
BATCH = 2
SEQ = 16384
DEPTH = 2

GRID_W = 64
CTX_LEN = 256
EPS = 1e-6

CONV_DIM = 512
CONV_WIDTH = 31
CONV_PAD = CONV_WIDTH // 2
DIFF_HEADS = 4
DIFF_HD = 64
DIFF_VD = 2 * DIFF_HD
DIFF_QK = DIFF_HEADS * 2 * DIFF_HD
DIFF_DIM = DIFF_HEADS * DIFF_VD
DIFF_SCALE = DIFF_HD ** -0.5
ATTN_BLOCK = 128
ROPE_BASE = 10000.0
AB_Q0 = 2 * CONV_DIM
AB_K0 = AB_Q0 + DIFF_QK
AB_V0 = AB_K0 + DIFF_QK
AB_IN = AB_V0 + DIFF_DIM

GLA_HEADS = 4
GLA_DK = D_MODEL // (2 * GLA_HEADS)
GLA_DV = D_MODEL // GLA_HEADS
GLA_KDIM = GLA_HEADS * GLA_DK
GLA_VDIM = GLA_HEADS * GLA_DV
GLA_RANK = 16
GLA_TAU = 16.0
GLA_CHUNK = 64
GLA_K0 = GLA_KDIM
GLA_V0 = 2 * GLA_KDIM
GLA_G0 = GLA_V0 + GLA_VDIM
GLA_A0 = GLA_G0 + GLA_VDIM
GLA_IN = GLA_A0 + 2 * GLA_RANK

N_GROUPS = 4
EXPERTS_PER_GROUP = 8
N_EXPERTS = N_GROUPS * EXPERTS_PER_GROUP
TOP_K = 2
D_EXPERT = 512
MOE_BLOCK = 256

kernel_name = 'hybrid_conv_diffattn_gla_hmoe_dit'


def rmsnorm(x, g):
    xf = x.astype(jnp.float32)
    y = xf * lax.rsqrt(jnp.mean(xf * xf, axis=-1, keepdims=True) + EPS)
    return (y * g.astype(jnp.float32)).astype(x.dtype)


def layernorm(x, g, b):
    xf = x.astype(jnp.float32)
    mu = jnp.mean(xf, axis=-1, keepdims=True)
    var = jnp.mean(jnp.square(xf - mu), axis=-1, keepdims=True)
    y = (xf - mu) * lax.rsqrt(var + EPS)
    return (y * g.astype(jnp.float32) + b.astype(jnp.float32)).astype(x.dtype)


def axial_rope_tables(n_lat):
    rows = n_lat // GRID_W
    r, col = jnp.meshgrid(jnp.arange(rows, dtype=jnp.float32),
                          jnp.arange(GRID_W, dtype=jnp.float32), indexing='ij')
    half = DIFF_HD // 2
    inv = ROPE_BASE ** (-jnp.arange(0, half, 2, dtype=jnp.float32) / half)
    ar = r.reshape(-1, 1) * inv
    ac = col.reshape(-1, 1) * inv
    ang = jnp.concatenate([ar, ar, ac, ac], axis=-1)
    return jnp.cos(ang), jnp.sin(ang)


def apply_rope(t, cos, sin):
    tr = t.reshape(t.shape[:-1] + (2, 2, DIFF_HD // 4))
    rot = jnp.stack([-tr[..., 1, :], tr[..., 0, :]], axis=-2).reshape(t.shape)
    cs = cos[:, None, None, :].astype(t.dtype)
    sn = sin[:, None, None, :].astype(t.dtype)
    return t * cs + rot * sn


def conformer_conv(a, g, w, b, ln_g, ln_b):
    h = a * jax.nn.sigmoid(g)
    h = lax.conv_general_dilated(h, w[:, None, :].astype(h.dtype), (1,), ((CONV_PAD, CONV_PAD),),
                                 dimension_numbers=('NWC', 'WIO', 'NWC'),
                                 feature_group_count=CONV_DIM) + b
    return jax.nn.silu(layernorm(h, ln_g, ln_b))


def conv_diffattn_mixer(nl, nc, w_in, conv_w, conv_b, ln_g, ln_b, qn_g, kn_g, lq1, lk1, lq2, lk2,
                        subln_g, w_out, lambda_init, cos, sin, need_ctx):
    bsz, n_lat, _ = nl.shape
    ul = nl @ w_in
    uc = nc @ w_in

    def qkv(u):
        b_, L = u.shape[:2]
        q = rmsnorm(u[..., AB_Q0:AB_K0].reshape(b_, L, DIFF_HEADS, 2, DIFF_HD), qn_g)
        k = rmsnorm(u[..., AB_K0:AB_V0].reshape(b_, L, DIFF_HEADS, 2, DIFF_HD), kn_g)
        v = u[..., AB_V0:].reshape(b_, L, DIFF_HEADS, DIFF_VD)
        return q, k, v

    ql, kl, vl = qkv(ul)
    qc, kc, vc = qkv(uc)
    ql = apply_rope(ql, cos, sin)
    kl = apply_rope(kl, cos, sin)
    lam = (jnp.exp(jnp.sum(lq1 * lk1).astype(jnp.float32))
           - jnp.exp(jnp.sum(lq2 * lk2).astype(jnp.float32)) + lambda_init)

    tq = lambda t: t.transpose(0, 2, 3, 1, 4)
    tv = lambda t: t.transpose(0, 2, 1, 3)

    def diff_softmax(q, k, v):
        s = jnp.einsum('bhmqd,bhmkd->bhmqk', q, k).astype(jnp.float32) * DIFF_SCALE
        p = jax.nn.softmax(s, axis=-1)
        a = p[:, :, 0] - lam * p[:, :, 1]
        return jnp.einsum('bhqk,bhkd->bhqd', a.astype(v.dtype), v)

    k_all = jnp.concatenate([tq(kc), tq(kl)], axis=3)
    v_all = jnp.concatenate([tv(vc), tv(vl)], axis=2)
    nb = n_lat // ATTN_BLOCK
    qb = tq(ql).reshape(bsz, DIFF_HEADS, 2, nb, ATTN_BLOCK, DIFF_HD).transpose(3, 0, 1, 2, 4, 5)
    ob = lax.map(lambda q: diff_softmax(q, k_all, v_all), qb)
    o_l = ob.transpose(1, 0, 3, 2, 4).reshape(bsz, n_lat, DIFF_HEADS, DIFF_VD)

    def finish(o, u):
        b_, L = u.shape[:2]
        attn = (rmsnorm(o, subln_g) * (1.0 - lambda_init)).reshape(b_, L, DIFF_DIM)
        conv = conformer_conv(u[..., :CONV_DIM], u[..., CONV_DIM:AB_Q0], conv_w, conv_b, ln_g, ln_b)
        return jnp.concatenate([conv, attn], axis=-1) @ w_out

    y_l = finish(o_l, ul)
    y_c = None
    if need_ctx:
        o_c = diff_softmax(tq(qc), tq(kc), tv(vc)).transpose(0, 2, 1, 3)
        y_c = finish(o_c, uc)
    return y_l, y_c


def gla_chunked(q, k, v, log_a, s0):
    bsz, nh, L, dk = q.shape
    dv = v.shape[-1]
    n = L // GLA_CHUNK

    def chunks(t):
        return t.astype(jnp.float32).reshape(bsz, nh, n, GLA_CHUNK, t.shape[-1]).transpose(2, 0, 1, 3, 4)

    incl = jnp.tril(jnp.ones((GLA_CHUNK, GLA_CHUNK), dtype=bool))[:, :, None]

    def step(state, inp):
        qc, kc, vc, ac = inp
        b = jnp.cumsum(ac, axis=-2)
        b_end = b[..., -1:, :]
        o_inter = jnp.einsum('bhid,bhde->bhie', qc * jnp.exp(b), state)
        decay = jnp.exp(jnp.where(incl, b[..., :, None, :] - b[..., None, :, :], -jnp.inf))
        att = jnp.einsum('bhid,bhjd,bhijd->bhij', qc, kc, decay)
        o = o_inter + jnp.einsum('bhij,bhje->bhie', att, vc)
        state = (jnp.exp(b_end[..., 0, :])[..., None] * state
                 + jnp.einsum('bhjd,bhje->bhde', kc * jnp.exp(b_end - b), vc))
        return state, o

    s_end, o = lax.scan(step, s0, (chunks(q), chunks(k), chunks(v), chunks(log_a)))
    return o.transpose(1, 2, 0, 3, 4).reshape(bsz, nh, L, dv).astype(v.dtype), s_end


def bigla_mixer(nl, nc, w_in, w_a2, b_a2, norm_g, w_out, need_ctx):
    def project(h):
        bsz, L, _ = h.shape
        u = h @ w_in
        heads = lambda t, dh: t.reshape(bsz, L, GLA_HEADS, dh).transpose(0, 2, 1, 3)
        q = heads(u[..., :GLA_K0], GLA_DK) * (GLA_DK ** -0.5)
        k = heads(u[..., GLA_K0:GLA_V0], GLA_DK)
        v = heads(u[..., GLA_V0:GLA_G0], GLA_DV)
        g = u[..., GLA_G0:GLA_A0]
        a1 = u[..., GLA_A0:].reshape(bsz, L, 2, GLA_RANK)
        z = jnp.einsum('bldr,drk->bldk', a1, w_a2) + b_a2
        log_a = jax.nn.log_sigmoid(z.astype(jnp.float32)) / GLA_TAU
        return q, k, v, g, heads(log_a[:, :, 0], GLA_DK), heads(log_a[:, :, 1], GLA_DK)

    flip = lambda t: jnp.flip(t, axis=2)
    qc, kc, vc, gc, afc, abc = project(nc)
    ql, kl, vl, gl, afl, abl = project(nl)
    s0 = jnp.zeros((nc.shape[0], GLA_HEADS, GLA_DK, GLA_DV), jnp.float32)
    o_cf, s_cf = gla_chunked(qc, kc, vc, afc, s0)
    o_cb_rev, s_cb = gla_chunked(flip(qc), flip(kc), flip(vc), flip(abc), s0)
    o_lf, _ = gla_chunked(ql, kl, vl, afl, s_cf)
    o_lb_rev, _ = gla_chunked(flip(ql), flip(kl), flip(vl), flip(abl), s_cb)

    def out(o_f, o_b_rev, g):
        bsz, _, L, _ = o_f.shape
        o = (o_f + flip(o_b_rev)).transpose(0, 2, 1, 3)
        o = rmsnorm(o, norm_g).reshape(bsz, L, GLA_VDIM)
        return (o * jax.nn.silu(g)) @ w_out

    y_l = out(o_lf, o_lb_rev, gl)
    y_c = out(o_cf, o_cb_rev, gc) if need_ctx else None
    return y_l, y_c


def hier_moe(xt, rg_w, rg_b, re_w, re_b, w1, w3, w2):
    n_tok, d = xt.shape
    lg = (xt @ rg_w).astype(jnp.float32) + rg_b
    pg = jax.nn.softmax(lg, axis=-1)
    _, gi = lax.top_k(lg, 1)
    pg_sel = jnp.take_along_axis(pg, gi, axis=-1)
    le = ((xt @ re_w).astype(jnp.float32) + re_b).reshape(n_tok, N_GROUPS, EXPERTS_PER_GROUP)
    le_sel = jnp.take_along_axis(
        le, jnp.broadcast_to(gi[:, :, None], (n_tok, 1, EXPERTS_PER_GROUP)), axis=1)[:, 0]
    top_v, top_i = lax.top_k(le_sel, TOP_K)
    gate = pg_sel * jax.nn.softmax(top_v, axis=-1)
    expert = gi * EXPERTS_PER_GROUP + top_i

    n_slot = n_tok * TOP_K
    e_flat = expert.reshape(-1)
    g_flat = gate.reshape(-1)
    tok = jnp.arange(n_slot, dtype=jnp.int32) // TOP_K
    order = jnp.argsort(e_flat)
    se = e_flat[order]
    counts = jnp.bincount(e_flat, length=N_EXPERTS)
    offs = jnp.cumsum(counts) - counts
    pcounts = (counts + MOE_BLOCK - 1) // MOE_BLOCK * MOE_BLOCK
    pends = jnp.cumsum(pcounts)
    poffs = pends - pcounts
    dest = poffs[se] + jnp.arange(n_slot, dtype=jnp.int32) - offs[se]
    n_blk = (n_slot + N_EXPERTS * (MOE_BLOCK - 1) + MOE_BLOCK - 1) // MOE_BLOCK
    n_row = n_blk * MOE_BLOCK
    row_tok = jnp.full((n_row,), n_tok, jnp.int32).at[dest].set(tok[order])
    row_gate = jnp.zeros((n_row,), jnp.float32).at[dest].set(g_flat[order])
    blk_exp = jnp.minimum(jnp.searchsorted(pends, jnp.arange(n_blk, dtype=jnp.int32) * MOE_BLOCK,
                                           side='right'), N_EXPERTS - 1)
    x_rows = jnp.concatenate([xt, jnp.zeros((1, d), xt.dtype)])[row_tok].reshape(n_blk, MOE_BLOCK, d)

    def expert_block(args):
        xb, e = args
        h = jax.nn.silu(xb @ w1[e]) * (xb @ w3[e])
        return h @ w2[e]

    y_rows = lax.map(expert_block, (x_rows, blk_exp)).reshape(n_row, d)
    y = jax.ops.segment_sum(y_rows * row_gate[:, None].astype(y_rows.dtype), row_tok,
                            num_segments=n_tok + 1)
    return y[:n_tok]


def setup_inputs(seed: int = 0) -> dict:
    key = jax.random.key(seed)
    ks = iter(jax.random.split(key, 40))

    def nrm(shape, scale):
        return jax.random.normal(next(ks), shape, jnp.float32) * scale

    def gain(shape):
        return 1.0 + nrm(shape, 0.02)

    ne, no = (DEPTH + 1) // 2, DEPTH // 2
    d = D_MODEL
    return {
        'x': nrm((BATCH, SEQ, d), 1.0),
        'c': nrm((BATCH, d), 1.0),
        'ctx': nrm((BATCH, CTX_LEN, d), 1.0),
        'c_ctx': nrm((d,), 1.0),
        'ada_w': nrm((DEPTH, d, 6 * d), 0.5 * d ** -0.5),
        'ada_b': nrm((DEPTH, 6 * d), 0.01),
        'norm1_g': gain((DEPTH, d)),
        'norm2_g': gain((DEPTH, d)),
        'ab_w_in': nrm((ne, d, AB_IN), d ** -0.5),
        'conv_w': nrm((ne, CONV_WIDTH, CONV_DIM), CONV_WIDTH ** -0.5),
        'conv_b': nrm((ne, CONV_DIM), 0.01),
        'conv_ln_g': gain((ne, CONV_DIM)),
        'conv_ln_b': nrm((ne, CONV_DIM), 0.01),
        'diff_qnorm_g': gain((ne, DIFF_HD)),
        'diff_knorm_g': gain((ne, DIFF_HD)),
        'diff_lq1': nrm((ne, DIFF_HD), 0.1),
        'diff_lk1': nrm((ne, DIFF_HD), 0.1),
        'diff_lq2': nrm((ne, DIFF_HD), 0.1),
        'diff_lk2': nrm((ne, DIFF_HD), 0.1),
        'diff_subln_g': gain((ne, DIFF_VD)),
        'ab_w_out': nrm((ne, CONV_DIM + DIFF_DIM, d), (CONV_DIM + DIFF_DIM) ** -0.5),
        'gla_w_in': nrm((no, d, GLA_IN), d ** -0.5),
        'gla_w_a2': nrm((no, 2, GLA_RANK, GLA_KDIM), GLA_RANK ** -0.5),
        'gla_b_a2': nrm((no, 2, GLA_KDIM), 0.1),
        'gla_norm_g': gain((no, GLA_DV)),
        'gla_w_out': nrm((no, GLA_VDIM, d), GLA_VDIM ** -0.5),
        'rg_w': nrm((DEPTH, d, N_GROUPS), d ** -0.5),
        'rg_b': nrm((DEPTH, N_GROUPS), 0.01),
        're_w': nrm((DEPTH, d, N_EXPERTS), d ** -0.5),
        're_b': nrm((DEPTH, N_EXPERTS), 0.01),
        'moe_w1': nrm((DEPTH, N_EXPERTS, d, D_EXPERT), d ** -0.5),
        'moe_w3': nrm((DEPTH, N_EXPERTS, d, D_EXPERT), d ** -0.5),
        'moe_w2': nrm((DEPTH, N_EXPERTS, D_EXPERT, d), D_EXPERT ** -0.5),
    }


def reference(x, c, ctx, c_ctx, ada_w, ada_b, norm1_g, norm2_g, ab_w_in, conv_w, conv_b, conv_ln_g,
              conv_ln_b, diff_qnorm_g, diff_knorm_g, diff_lq1, diff_lk1, diff_lq2, diff_lk2,
              diff_subln_g, ab_w_out, gla_w_in, gla_w_a2, gla_b_a2, gla_norm_g, gla_w_out,
              rg_w, rg_b, re_w, re_b, moe_w1, moe_w3, moe_w2):
    bsz, n_lat, d = x.shape
    cos, sin = axial_rope_tables(n_lat)
    s_lat = jax.nn.silu(c)
    s_ctx = jax.nn.silu(c_ctx)
    hl, hc = x, ctx
    for l in range(DEPTH):
        last = l == DEPTH - 1
        i = l // 2
        ml = jnp.split((s_lat @ ada_w[l] + ada_b[l])[:, None, :], 6, axis=-1)
        mc = jnp.split(s_ctx @ ada_w[l] + ada_b[l], 6, axis=-1)
        nl = rmsnorm(hl, norm1_g[l]) * (1 + ml[1]) + ml[0]
        nc = rmsnorm(hc, norm1_g[l]) * (1 + mc[1]) + mc[0]
        if l % 2 == 0:
            lambda_init = 0.8 - 0.6 * math.exp(-0.3 * l)
            yl, yc = conv_diffattn_mixer(nl, nc, ab_w_in[i], conv_w[i], conv_b[i], conv_ln_g[i],
                                         conv_ln_b[i], diff_qnorm_g[i], diff_knorm_g[i],
                                         diff_lq1[i], diff_lk1[i], diff_lq2[i], diff_lk2[i],
                                         diff_subln_g[i], ab_w_out[i], lambda_init, cos, sin,
                                         not last)
        else:
            yl, yc = bigla_mixer(nl, nc, gla_w_in[i], gla_w_a2[i], gla_b_a2[i], gla_norm_g[i],
                                 gla_w_out[i], not last)
        hl = hl + ml[2] * yl
        nl = rmsnorm(hl, norm2_g[l]) * (1 + ml[4]) + ml[3]
        if last:
            y = hier_moe(nl.reshape(-1, d), rg_w[l], rg_b[l], re_w[l], re_b[l],
                         moe_w1[l], moe_w3[l], moe_w2[l])
            hl = hl + ml[5] * y.reshape(hl.shape)
        else:
            hc = hc + mc[2] * yc
            nc = rmsnorm(hc, norm2_g[l]) * (1 + mc[4]) + mc[3]
            n_l = bsz * n_lat
            y = hier_moe(jnp.concatenate([nl.reshape(-1, d), nc.reshape(-1, d)], axis=0),
                         rg_w[l], rg_b[l], re_w[l], re_b[l], moe_w1[l], moe_w3[l], moe_w2[l])
            hl = hl + ml[5] * y[:n_l].reshape(hl.shape)
            hc = hc + mc[5] * y[n_l:].reshape(hc.shape)
    return hl
```

```cpp
#define MK_PER_PHASE 0
#include <hip/hip_runtime.h>
#include <hip/hip_cooperative_groups.h>
#include <cstdio>
#include <cstdint>

namespace {
namespace cg = cooperative_groups;
constexpr int D = 1024, SEQ = 16384, CTX = 256, ROWS = SEQ + CTX;
constexpr float EPS = 1e-6f;

template <int CTRL> __device__ __forceinline__ float dpp_mov(float v) { return __int_as_float(__builtin_amdgcn_update_dpp(0, __float_as_int(v), CTRL, 0xf, 0xf, false)); }
__device__ __forceinline__ float row_sum16(float v) { v += dpp_mov<0xB1>(v); v += dpp_mov<0x4E>(v); v += dpp_mov<0x124>(v); v += dpp_mov<0x128>(v); return v; }
__device__ __forceinline__ float xor16_sum(float v) { auto r = __builtin_amdgcn_permlane16_swap(__float_as_uint(v), __float_as_uint(v), false, false); return __uint_as_float(r[0]) + __uint_as_float(r[1]); }
__device__ __forceinline__ float xor32_sum(float v) { auto r = __builtin_amdgcn_permlane32_swap(__float_as_uint(v), __float_as_uint(v), false, false); return __uint_as_float(r[0]) + __uint_as_float(r[1]); }
__device__ __forceinline__ float half_sum32(float v) { return xor16_sum(row_sum16(v)); }
__device__ __forceinline__ float wave_sum(float v) { return xor32_sum(xor16_sum(row_sum16(v))); }
#define LAS __attribute__((address_space(3)))
typedef unsigned short bf16_t;
typedef short bf16x8 __attribute__((ext_vector_type(8)));
typedef float f32x4 __attribute__((ext_vector_type(4)));
typedef float f32x16 __attribute__((ext_vector_type(16)));
typedef unsigned u32x4 __attribute__((ext_vector_type(4)));
typedef unsigned u32x2 __attribute__((ext_vector_type(2)));
typedef float f32x2_t __attribute__((ext_vector_type(2)));
typedef __bf16 bf16x2_t __attribute__((ext_vector_type(2)));

constexpr int RTOT = 2 * ROWS;
constexpr int NWAVES = 8, NTHR = 512;
constexpr int LDS_BYTES = 155648;
constexpr float LOG2E = 1.4426950408889634f;
constexpr float QSCALE = 0.125f * LOG2E;

__device__ __forceinline__ unsigned cvtpk(float lo, float hi) { f32x2_t v = {lo, hi}; bf16x2_t b = __builtin_convertvector(v, bf16x2_t); return __builtin_bit_cast(unsigned, b); }
__device__ __forceinline__ float bf2f(bf16_t h) { return __uint_as_float((unsigned)h << 16); }
__device__ __forceinline__ float fsigmoid(float x) { return __builtin_amdgcn_rcpf(1.f + __builtin_amdgcn_exp2f(-x * LOG2E)); }
__device__ __forceinline__ float fsilu(float x) { return x * fsigmoid(x); }

namespace pg8 {
constexpr int BM = 256, BK = 64, HALF = 128, HTB = HALF * BK * 2, STAGE_BYTES = 8 * HTB, NXCD = 8, WGM = 8;
__host__ __device__ __forceinline__ int lds_byte(int r, int c) { const int st = (r >> 4) * 2 + (c >> 5), rr = r & 15, cc = c & 31, ob = rr * 64 + cc * 2; return st * 1024 + (ob ^ (((ob >> 9) & 1) << 5)); }
__host__ __device__ __forceinline__ void stage_rc(int b, int& R, int& C) { const int st = b / 1024, sb = b % 1024, swz = sb ^ (((sb >> 9) & 1) << 5); R = (st >> 1) * 16 + swz / 64; C = (st & 1) * 32 + (swz % 64) / 2; }
__host__ __device__ __forceinline__ int perm32(int rho) { const int n = rho >> 4, i = rho & 15; return 8 * (i >> 2) + 4 * n + (i & 3); }

struct Unit { int pm, pn, e, j; };
struct Gemm { const bf16_t* A; const bf16_t* Bt; int K; long bstride; const int* aidx; const int* cnt; int cap; };

struct StaticOrder {
    int nM, nN, nwg, G, c;
    __device__ void init(int M, int N, int G_, int c_) { nM = M / BM; nN = N / BM; nwg = nM * nN; G = G_; c = c_; }
    __device__ bool next(int i, Unit& u) const {
        const long L = (long)i * G + c; if (L >= nwg) return false;
        int wgid = (int)L; { const int q = nwg / NXCD, r = nwg % NXCD, xcd = wgid % NXCD, off = wgid / NXCD; wgid = (xcd < r ? xcd * (q + 1) : r * (q + 1) + (xcd - r) * q) + off; }
        const int nig = WGM * nN, gid = wgid / nig, fm = gid * WGM, gsz = (nM - fm) < WGM ? (nM - fm) : WGM;
        u.pm = fm + ((wgid % nig) % gsz); u.pn = (wgid % nig) / gsz; u.e = 0; u.j = 0; return true;
    }
};

template <bool GATHER, class Epi, class Sched>
__device__ __forceinline__ void gemm_phase(LAS unsigned char* lds, const Gemm g, const Sched& S, const Epi& E) {
    const int tid = threadIdx.x, wid = __builtin_amdgcn_readfirstlane(tid >> 6), lane = tid & 63, wr = wid >> 2, wc = wid & 3, fr = lane & 15, fq = lane >> 4;
    const int K = g.K, nt = K / BK;
    int Rst[2], Cst[2]; unsigned voffB[2];
#pragma unroll
    for (int i = 0; i < 2; ++i) { int R, C; stage_rc(tid * 16 + i * 8192, R, C); Rst[i] = R; Cst[i] = C; const int Rb = Epi::PERM ? ((R & ~31) + perm32(R & 31)) : R; voffB[i] = (unsigned)(Rb * K + C) * 2u; }
    const size_t kstep = (size_t)(BK * 2);
    const size_t hstep = (size_t)HALF * K * 2;
    const size_t tstep = 2 * hstep;
    const unsigned ldsw = (unsigned)wid * 1024u;
    const int aoff = lds_byte(wr * 64 + fr, fq * 8), boff = lds_byte(wc * 32 + fr, fq * 8);
#define PG8_SA(b, h) (((b) * 2 + (h)) * HTB)
#define PG8_SB(b, h) ((4 + (b) * 2 + (h)) * HTB)
#define PG8_STAGE(bufoff, gbase, voff) do { _Pragma("unroll") for (int _i = 0; _i < 2; ++_i) \
        __builtin_amdgcn_global_load_lds((const unsigned*)((const char*)(gbase) + (voff)[_i]), (LAS unsigned*)(lds + (bufoff) + ldsw + _i * 8192), 16, 0, 0); } while (0)
#define PG8_LDA(dst, b, h) do { _Pragma("unroll") for (int m = 0; m < 4; ++m) _Pragma("unroll") for (int k = 0; k < 2; ++k) dst[m][k] = *(const LAS bf16x8*)(lds + PG8_SA(b, h) + aoff + m * 2048 + k * 1024); } while (0)
#define PG8_LDB(dst, b, h) do { _Pragma("unroll") for (int n = 0; n < 2; ++n) _Pragma("unroll") for (int k = 0; k < 2; ++k) dst[n][k] = *(const LAS bf16x8*)(lds + PG8_SB(b, h) + boff + n * 2048 + k * 1024); } while (0)
#define PG8_MMA(ai, bj, At, Bt) do { __builtin_amdgcn_s_setprio(1); _Pragma("unroll") for (int m = 0; m < 4; ++m) _Pragma("unroll") for (int n = 0; n < 2; ++n) _Pragma("unroll") for (int k = 0; k < 2; ++k) \
        acc[ai][bj][m][n] = __builtin_amdgcn_mfma_f32_16x16x32_bf16(Bt[n][k], At[m][k], acc[ai][bj][m][n], 0, 0, 0); __builtin_amdgcn_s_setprio(0); } while (0)
#define PG8_WAIT_V(n) asm volatile("s_waitcnt vmcnt(" #n ")" ::: "memory")
#define PG8_WAIT_L(n) asm volatile("s_waitcnt lgkmcnt(" #n ")" ::: "memory")
#define PG8_BAR __builtin_amdgcn_s_barrier()
#define PG8_SCHED __builtin_amdgcn_sched_barrier(0)
#define PG8_AOFFS(dst, u) do { _Pragma("unroll") for (int _h = 0; _h < 2; ++_h) _Pragma("unroll") for (int _i = 0; _i < 2; ++_i) { const int _R = 128 * _h + Rst[_i]; long _row; \
        if (GATHER) { const int _p = 256 * (u).j + _R; _row = (_p < g.cnt[(u).e]) ? g.aidx[(size_t)(u).e * g.cap + _p] : 0; } else _row = 256L * (u).pm + _R; \
        dst[_h][_i] = (unsigned)((_row * K + Cst[_i]) * 2); } } while (0)
    Unit cur, nxt; int ui = 0;
    if (!S.next(0, cur)) return;
    f32x4 acc[2][2][4][2];
#pragma unroll
    for (int a = 0; a < 2; ++a)
#pragma unroll
        for (int b = 0; b < 2; ++b)
#pragma unroll
            for (int m = 0; m < 4; ++m)
#pragma unroll
                for (int n = 0; n < 2; ++n) acc[a][b][m][n] = (f32x4){0.f, 0.f, 0.f, 0.f};
    bf16x8 At[4][2], B0[2][2], B1[2][2];
    unsigned oa[2][2], na[2][2];
    PG8_AOFFS(oa, cur);
    const char* const Ab = (const char*)g.A;
    const char* cB = (const char*)g.Bt + ((size_t)cur.e * g.bstride) * 2 + (size_t)cur.pn * tstep;
    PG8_STAGE(PG8_SB(0, 0), cB, voffB); PG8_STAGE(PG8_SB(0, 1), cB + hstep, voffB); PG8_STAGE(PG8_SA(0, 0), Ab, oa[0]); PG8_STAGE(PG8_SA(0, 1), Ab, oa[1]);
    if (wr == 1) PG8_BAR;
    PG8_WAIT_V(2); PG8_BAR;
    PG8_STAGE(PG8_SB(1, 0), cB + kstep, voffB); PG8_STAGE(PG8_SA(1, 0), Ab + kstep, oa[0]); PG8_STAGE(PG8_SB(1, 1), cB + hstep + kstep, voffB);
    PG8_WAIT_V(6); PG8_BAR;
    for (;;) {
        const bool has_next = S.next(ui + 1, nxt);
        if (has_next) { PG8_AOFFS(na, nxt); } else {
#pragma unroll
            for (int _h = 0; _h < 2; ++_h)
#pragma unroll
                for (int _i = 0; _i < 2; ++_i) na[_h][_i] = oa[_h][_i]; }
        const char* nB = has_next ? (const char*)g.Bt + ((size_t)nxt.e * g.bstride) * 2 + (size_t)nxt.pn * tstep : cB;
        for (int t = 0; t < nt; t += 2) {
            const bool last = (t == nt - 2);
            const char* a1 = Ab + (size_t)(t + 1) * kstep;
            const char* a2 = last ? Ab : Ab + (size_t)(t + 2) * kstep; const char* b2 = last ? nB : cB + (size_t)(t + 2) * kstep;
            const char* a3 = a2 + kstep; const char* b3 = b2 + kstep;
            unsigned x2[2][2];
#pragma unroll
            for (int _h = 0; _h < 2; ++_h)
#pragma unroll
                for (int _i = 0; _i < 2; ++_i) x2[_h][_i] = last ? na[_h][_i] : oa[_h][_i];
            PG8_LDB(B0, 0, 0); PG8_LDB(B1, 0, 1); PG8_SCHED; PG8_LDA(At, 0, 0); PG8_STAGE(PG8_SA(1, 1), a1, oa[1]);
            PG8_WAIT_V(8); PG8_WAIT_L(0); PG8_BAR; PG8_MMA(0, 0, At, B0); PG8_MMA(0, 1, At, B1); PG8_BAR; PG8_SCHED;
            PG8_LDA(At, 0, 1); PG8_STAGE(PG8_SB(0, 0), b2, voffB); PG8_STAGE(PG8_SB(0, 1), b2 + hstep, voffB); PG8_STAGE(PG8_SA(0, 0), a2, x2[0]);
            PG8_WAIT_V(8); PG8_WAIT_L(0); PG8_BAR; PG8_MMA(1, 0, At, B0); PG8_MMA(1, 1, At, B1); PG8_BAR; PG8_SCHED;
            PG8_LDB(B0, 1, 0); PG8_LDB(B1, 1, 1); PG8_SCHED; PG8_LDA(At, 1, 0); PG8_STAGE(PG8_SA(0, 1), a2, x2[1]);
            PG8_WAIT_V(8); PG8_WAIT_L(0); PG8_BAR; PG8_MMA(0, 0, At, B0); PG8_MMA(0, 1, At, B1); PG8_BAR; PG8_SCHED;
            PG8_LDA(At, 1, 1); PG8_STAGE(PG8_SB(1, 0), b3, voffB); PG8_STAGE(PG8_SB(1, 1), b3 + hstep, voffB); PG8_STAGE(PG8_SA(1, 0), a3, x2[0]);
            PG8_WAIT_V(8); PG8_WAIT_L(0); PG8_BAR; PG8_MMA(1, 0, At, B0); PG8_MMA(1, 1, At, B1); PG8_BAR; PG8_SCHED;
        }
        if (wr == 0) PG8_BAR;
        E(acc, cur, wr, wc, fr, fq);
        if (!has_next) break;
#pragma unroll
        for (int a = 0; a < 2; ++a)
#pragma unroll
            for (int b = 0; b < 2; ++b)
#pragma unroll
                for (int m = 0; m < 4; ++m)
#pragma unroll
                    for (int n = 0; n < 2; ++n) acc[a][b][m][n] = (f32x4){0.f, 0.f, 0.f, 0.f};
        cur = nxt; cB = nB; ++ui;
#pragma unroll
        for (int _h = 0; _h < 2; ++_h)
#pragma unroll
            for (int _i = 0; _i < 2; ++_i) oa[_h][_i] = na[_h][_i];
        if (wr == 1) PG8_BAR;
    }
    PG8_WAIT_V(0);
    PG8_BAR;
#undef PG8_SA
#undef PG8_SB
#undef PG8_STAGE
#undef PG8_LDA
#undef PG8_LDB
#undef PG8_MMA
#undef PG8_WAIT_V
#undef PG8_WAIT_L
#undef PG8_BAR
#undef PG8_SCHED
#undef PG8_AOFFS
}
}
struct Args { const float* in[33]; float* out; unsigned char* ws; int ph_lo, ph_hi, row0, nrows, layer, pad; };
enum { IN_X = 0, IN_C, IN_CTX, IN_CCTX, IN_ADAW, IN_ADAB, IN_N1G, IN_N2G, IN_ABWIN, IN_CONVW, IN_CONVB, IN_CLNG, IN_CLNB, IN_QNG, IN_KNG, IN_LQ1, IN_LK1, IN_LQ2, IN_LK2,
       IN_SUBLN, IN_ABWOUT, IN_GLAWIN, IN_GLAWA2, IN_GLABA2, IN_GLANG, IN_GLAWOUT, IN_RGW, IN_RGB, IN_REW, IN_REB, IN_W1, IN_W3, IN_W2 };
enum { P_PRO_A = 0, P_PRO_B, P_INL0, P_ATT, P_OUTL0, P_ROUTE0, P_UP0, P_DOWN0, P_COMB0, P_INL1, P_GPREP, P_GSCAN, P_GOUT, P_OUTL1, P_ROUTE1, P_UP1, P_DOWN1, P_COMB1, P_COUNT };

struct Frame {
    LAS unsigned char* lds; int tid, lane, wave, G, bid;
};

constexpr size_t MiB = 1u << 20;
constexpr size_t FW_MODS = 0;
constexpr size_t FW_ROPE = 256 * 1024;
constexpr size_t FW_SCAL = FW_ROPE + 64 * 1024;
constexpr size_t FW_CTL = 512 * 1024;
constexpr size_t FW_WIN0 = 1 * MiB;
constexpr size_t FW_WOUT0 = 6 * MiB;
constexpr size_t FW_WIN1 = 8 * MiB;
constexpr size_t FW_WOUT1 = 15 * MiB;
constexpr size_t FW_W13 = 17 * MiB;
constexpr size_t FW_W2 = 81 * MiB;
constexpr size_t FW_HC = 113 * MiB;
constexpr size_t FW_RA = 115 * MiB, FW_RB = 180 * MiB, FW_RC = 310 * MiB, FW_RD = 440 * MiB, FW_RE = 450 * MiB, FW_RF = 515 * MiB, FW_END = 580 * MiB;

template <class Src>
__device__ __forceinline__ void conv_item(const float* W, int ldw, bf16_t* Bt, int K, int k0, int j0, Src src, LAS float* scr, int lane) {
    const int kr = lane >> 4, g = lane & 15; const int sc = src(j0 + 4 * g);
    f32x4 v[16];
#pragma unroll
    for (int i = 0; i < 16; ++i) v[i] = sc >= 0 ? *(const f32x4*)(W + (size_t)(k0 + 4 * i + kr) * ldw + sc) : (f32x4){0.f, 0.f, 0.f, 0.f};
#pragma unroll
    for (int i = 0; i < 16; ++i) { LAS float* d = scr + (4 * i + kr) * 65 + 4 * g; d[0] = v[i].x; d[1] = v[i].y; d[2] = v[i].z; d[3] = v[i].w; }
    asm volatile("s_waitcnt lgkmcnt(0)" ::: "memory");
    const int c = lane & 7, nr = lane >> 3;
#pragma unroll
    for (int jx = 0; jx < 8; ++jx) { const int n = nr + 8 * jx; const LAS float* s = scr + (8 * c) * 65 + n;
        u32x4 o; o.x = cvtpk(s[0 * 65], s[1 * 65]); o.y = cvtpk(s[2 * 65], s[3 * 65]); o.z = cvtpk(s[4 * 65], s[5 * 65]); o.w = cvtpk(s[6 * 65], s[7 * 65]);
        *(u32x4*)(Bt + (size_t)(j0 + n) * K + k0 + 8 * c) = o; }
    asm volatile("s_waitcnt lgkmcnt(0)" ::: "memory");
}
struct SrcWin0 {
    __device__ __forceinline__ int operator()(int j) const {
        const int pn = j >> 8, jl = j & 255;
        if (pn < 4) return (jl < 128) ? (128 * pn + jl) : (512 + 128 * pn + (jl - 128));
        if (pn < 8) { const int T = pn - 4, bj = jl >> 7, wc = (jl >> 5) & 3, fq = (jl >> 3) & 3, n = (jl >> 2) & 1, e = jl & 3;
            const int group = 4 * (T & 1) + wc, logical = bj * 32 + n * 16 + 4 * fq + e; return (T < 2 ? 1024 : 1536) + group * 64 + logical; }
        return j;
    }
};
struct SrcIdent { __device__ __forceinline__ int operator()(int j) const { return j; } };
struct SrcWin1 { __device__ __forceinline__ int operator()(int j) const { return j < 3104 ? j : -1; } };

__device__ __forceinline__ void phase_pro_a(const Frame& F, const Args& a) {
    float* mods = (float*)(a.ws + FW_MODS);
    if (F.bid < 192) {
        LAS float* s = (LAS float*)F.lds;
        LAS float* part = s + 3 * 1024;
        for (int i = F.tid; i < 3 * 1024; i += NTHR) { const int r = i >> 10, k = i & 1023; const float v = r < 2 ? a.in[IN_C][r * 1024 + k] : a.in[IN_CCTX][k]; s[i] = v / (1.f + expf(-v)); }
        __syncthreads();
        const int col = F.bid * 64 + F.lane;
        const int l = col / 6144, j = col % 6144;
        const float* w = a.in[IN_ADAW] + (size_t)l * 1024 * 6144 + j + (size_t)(F.wave * 128) * 6144;
        float a0 = 0.f, a1 = 0.f, a2 = 0.f;
#pragma unroll 16
        for (int k = 0; k < 128; ++k) { const float wv = w[(size_t)k * 6144]; const int kk = F.wave * 128 + k; a0 += s[kk] * wv; a1 += s[1024 + kk] * wv; a2 += s[2048 + kk] * wv; }
        part[(F.wave * 3 + 0) * 64 + F.lane] = a0; part[(F.wave * 3 + 1) * 64 + F.lane] = a1; part[(F.wave * 3 + 2) * 64 + F.lane] = a2;
        __syncthreads();
        if (F.tid < 192) { const int r = F.tid >> 6, ln = F.tid & 63; float acc = 0.f;
#pragma unroll
            for (int wv = 0; wv < 8; ++wv) acc += part[(wv * 3 + r) * 64 + ln];
            const int c2 = F.bid * 64 + ln; const int l2 = c2 / 6144, j2 = c2 % 6144;
            mods[(l2 * 3 + r) * 6144 + j2] = acc + a.in[IN_ADAB][l2 * 6144 + j2]; }
        __syncthreads();
    }
    if (F.bid >= 192 && F.bid < 200) {
        const int idx = (F.bid - 192) * NTHR + F.tid;
        const int pos = idx >> 4, i = idx & 15;
        const float inv = powf(10000.f, -(float)(2 * i) / 32.f); float sn, cs; sincosf((float)pos * inv, &sn, &cs);
        ((float2*)(a.ws + FW_ROPE))[idx] = make_float2(cs, sn);
    }
    if (F.bid == 200 && F.wave == 0) {
        float x = a.in[IN_LQ1][F.lane] * a.in[IN_LK1][F.lane], y = a.in[IN_LQ2][F.lane] * a.in[IN_LK2][F.lane];
        x = wave_sum(x); y = wave_sum(y);
        if (F.lane == 0) ((float*)(a.ws + FW_SCAL))[0] = expf(x) - expf(y) + 0.2f;
        float gq = fabsf(a.in[IN_QNG][F.lane]), gk = fabsf(a.in[IN_KNG][F.lane]);
#pragma unroll
        for (int o = 1; o < 64; o <<= 1) { gq = fmaxf(gq, __shfl_xor(gq, o)); gk = fmaxf(gk, __shfl_xor(gk, o)); }
        if (F.lane == 0) ((float*)(a.ws + FW_SCAL))[1] = exp2f(ceilf(fmaxf(0.f, 64.f * gq * gk * QSCALE - 8.5f)));
    }
    LAS float* scr = (LAS float*)(F.lds + F.wave * 16640);
    const int gw = F.bid * NWAVES + F.wave, NGW = F.G * NWAVES;
    constexpr int I_WIN0 = (2560 / 64) * (1024 / 64), I_WOUT0 = (1024 / 64) * (1024 / 64), I_WIN1 = (3328 / 64) * (1024 / 64);
    for (int it = gw; it < I_WIN0 + 2 * I_WOUT0 + I_WIN1; it += NGW) {
        int r = it;
        if (r < I_WIN0) { conv_item(a.in[IN_ABWIN], 2560, (bf16_t*)(a.ws + FW_WIN0), 1024, (r & 15) * 64, (r >> 4) * 64, SrcWin0{}, scr, F.lane); continue; } r -= I_WIN0;
        if (r < I_WOUT0) { conv_item(a.in[IN_ABWOUT], 1024, (bf16_t*)(a.ws + FW_WOUT0), 1024, (r & 15) * 64, (r >> 4) * 64, SrcIdent{}, scr, F.lane); continue; } r -= I_WOUT0;
        if (r < I_WOUT0) { conv_item(a.in[IN_GLAWOUT], 1024, (bf16_t*)(a.ws + FW_WOUT1), 1024, (r & 15) * 64, (r >> 4) * 64, SrcIdent{}, scr, F.lane); continue; } r -= I_WOUT0;
        conv_item(a.in[IN_GLAWIN], 3104, (bf16_t*)(a.ws + FW_WIN1), 1024, (r & 15) * 64, (r >> 4) * 64, SrcWin1{}, scr, F.lane);
    }
}

__device__ __forceinline__ void norm_mod_row(const float* h, const float* g, const float* msh, const float* msc, bf16_t* o, int lane) {
    const f32x4* hr = (const f32x4*)h + lane;
    f32x4 v[4]; float ss = 0.f;
#pragma unroll
    for (int j = 0; j < 4; ++j) { v[j] = hr[64 * j]; ss += (v[j].x * v[j].x + v[j].y * v[j].y) + (v[j].z * v[j].z + v[j].w * v[j].w); }
    const float rs = rsqrtf(wave_sum(ss) * (1.f / D) + EPS);
    u32x2* o8 = (u32x2*)o + lane;
#pragma unroll
    for (int j = 0; j < 4; ++j) { const int c = 4 * lane + 256 * j; const f32x4 gg = *(const f32x4*)(g + c), sh = *(const f32x4*)(msh + c), sc = *(const f32x4*)(msc + c);
        const f32x4 y = v[j] * rs * gg * (sc + 1.f) + sh; u32x2 w; w.x = cvtpk(y.x, y.y); w.y = cvtpk(y.z, y.w); o8[64 * j] = w; }
}
__device__ __forceinline__ void phase_pro_b(const Frame& F, const Args& a, bf16_t* N) {
    const float* mods = (const float*)(a.ws + FW_MODS);
    const int gw = F.bid * NWAVES + F.wave, NGW = F.G * NWAVES;
    for (int r = gw; r < a.nrows; r += 2 * NGW) {
        const int r2 = r + NGW; const bool two = r2 < a.nrows;
        const int rg = a.row0 + r, b = rg / ROWS, p = rg % ROWS; const int rgb = a.row0 + (two ? r2 : r), bb = rgb / ROWS, pb = rgb % ROWS;
        const float* h = p < CTX ? a.in[IN_CTX] + ((size_t)b * CTX + p) * D : a.in[IN_X] + ((size_t)b * SEQ + (p - CTX)) * D;
        const float* h2 = pb < CTX ? a.in[IN_CTX] + ((size_t)bb * CTX + pb) * D : a.in[IN_X] + ((size_t)bb * SEQ + (pb - CTX)) * D;
        const f32x4* hr = (const f32x4*)h + F.lane; const f32x4* hr2 = (const f32x4*)h2 + F.lane;
        f32x4 v[4], w[4]; float ss = 0.f, s2 = 0.f;
#pragma unroll
        for (int j = 0; j < 4; ++j) { v[j] = hr[64 * j]; w[j] = hr2[64 * j]; }
#pragma unroll
        for (int j = 0; j < 4; ++j) { ss += (v[j].x * v[j].x + v[j].y * v[j].y) + (v[j].z * v[j].z + v[j].w * v[j].w); s2 += (w[j].x * w[j].x + w[j].y * w[j].y) + (w[j].z * w[j].z + w[j].w * w[j].w); }
        const float rs = rsqrtf(wave_sum(ss) * (1.f / D) + EPS), rs2 = rsqrtf(wave_sum(s2) * (1.f / D) + EPS);
        const float* m = mods + (size_t)(p < CTX ? 2 : b) * 6144; const float* m2 = mods + (size_t)(pb < CTX ? 2 : bb) * 6144; const float* g = a.in[IN_N1G];
        u32x2* o8 = (u32x2*)(N + (size_t)r * D) + F.lane; u32x2* o82 = (u32x2*)(N + (size_t)(two ? r2 : r) * D) + F.lane;
#pragma unroll
        for (int j = 0; j < 4; ++j) { const int c = 4 * F.lane + 256 * j; const f32x4 gg = *(const f32x4*)(g + c);
            { const f32x4 sh = *(const f32x4*)(m + c), sc = *(const f32x4*)(m + 1024 + c); const f32x4 y = v[j] * rs * gg * (sc + 1.f) + sh; u32x2 q; q.x = cvtpk(y.x, y.y); q.y = cvtpk(y.z, y.w); o8[64 * j] = q; }
            if (two) { const f32x4 sh = *(const f32x4*)(m2 + c), sc = *(const f32x4*)(m2 + 1024 + c); const f32x4 y = w[j] * rs2 * gg * (sc + 1.f) + sh; u32x2 q; q.x = cvtpk(y.x, y.y); q.y = cvtpk(y.z, y.w); o82[64 * j] = q; } }
    }
}

struct EpiInL0 {
    static constexpr bool PERM = true;
    bf16_t *HH, *Q, *Kb, *V; const float* qn_g; const float* kn_g; const float2* rope; int rowbase;
    __device__ __forceinline__ void operator()(const f32x4 (&acc)[2][2][4][2], const pg8::Unit& u, int wr, int wc, int fr, int fq) const {
        const int pn = u.pn;
        asm volatile("" : "+v"(fr), "+v"(fq));
        if (pn < 4) {
#pragma unroll
            for (int ai = 0; ai < 2; ++ai)
#pragma unroll
                for (int m = 0; m < 4; ++m) { const int row = u.pm * 256 + ai * 128 + wr * 64 + m * 16 + fr;
                    float h[8];
#pragma unroll
                    for (int n = 0; n < 2; ++n)
#pragma unroll
                        for (int e = 0; e < 4; ++e) h[n * 4 + e] = acc[ai][0][m][n][e] * fsigmoid(acc[ai][1][m][n][e]);
                    u32x4 w; w.x = cvtpk(h[0], h[1]); w.y = cvtpk(h[2], h[3]); w.z = cvtpk(h[4], h[5]); w.w = cvtpk(h[6], h[7]);
                    *(u32x4*)(HH + (size_t)row * 512 + pn * 128 + wc * 32 + 8 * fq) = w; }
        } else if (pn < 8) {
            const bool isq = pn < 6; const int group = 4 * ((pn - 4) & 1) + wc;
            const float* gp = isq ? qn_g : kn_g; unsigned char* dst = (unsigned char*)(isq ? Q : Kb);
            const int p0 = (rowbase + u.pm * 256) % ROWS; const bool latent = p0 >= CTX;
#pragma unroll
            for (int ai = 0; ai < 2; ++ai)
#pragma unroll
                for (int m = 0; m < 4; ++m) { const int rl = ai * 128 + wr * 64 + m * 16 + fr; const int row = u.pm * 256 + rl;
                    float ss = 0.f;
#pragma unroll
                    for (int bj = 0; bj < 2; ++bj)
#pragma unroll
                        for (int n = 0; n < 2; ++n)
#pragma unroll
                            for (int e = 0; e < 4; ++e) { const float x = acc[ai][bj][m][n][e]; ss += x * x; }
                    ss = xor32_sum(xor16_sum(ss));
                    const float rs = rsqrtf(ss * (1.f / 64.f) + EPS) * (isq ? QSCALE : 1.f);
                    const int t = p0 + rl - CTX;
                    u32x4 w8;
#pragma unroll
                    for (int bj = 0; bj < 2; ++bj) { float y0[4], y1[4];
                        const f32x4 g0 = *(const f32x4*)(gp + bj * 32 + 4 * fq), g1 = *(const f32x4*)(gp + bj * 32 + 16 + 4 * fq);
#pragma unroll
                        for (int e = 0; e < 4; ++e) { y0[e] = acc[ai][bj][m][0][e] * rs * g0[e]; y1[e] = acc[ai][bj][m][1][e] * rs * g1[e]; }
                        if (latent) { const int pos = bj ? (t & 63) : (t >> 6); const f32x4* rp = (const f32x4*)(rope + pos * 16 + 4 * fq); const f32x4 c01 = rp[0], c23 = rp[1];
                            const float cs[4] = {c01.x, c01.z, c23.x, c23.z}, sn[4] = {c01.y, c01.w, c23.y, c23.w};
#pragma unroll
                            for (int e = 0; e < 4; ++e) { const float a0 = y0[e], a1 = y1[e]; y0[e] = a0 * cs[e] - a1 * sn[e]; y1[e] = a1 * cs[e] + a0 * sn[e]; } }
                        int wa = 0, wb = 0; wa = __builtin_amdgcn_cvt_pk_fp8_f32(y0[0], y0[1], wa, false); wa = __builtin_amdgcn_cvt_pk_fp8_f32(y0[2], y0[3], wa, true);
                        wb = __builtin_amdgcn_cvt_pk_fp8_f32(y1[0], y1[1], wb, false); wb = __builtin_amdgcn_cvt_pk_fp8_f32(y1[2], y1[3], wb, true);
                        if (bj == 0) { w8.x = (unsigned)wa; w8.y = (unsigned)wb; } else { w8.z = (unsigned)wa; w8.w = (unsigned)wb; } }
                    *(u32x4*)(dst + (size_t)row * 512 + group * 64 + 16 * fq) = w8; }
        } else {
            unsigned char* V8 = (unsigned char*)V;
#pragma unroll
            for (int ai = 0; ai < 2; ++ai) { const int tile = (rowbase + u.pm * 256 + ai * 128 + wr * 64) >> 6;
#pragma unroll
                for (int bj = 0; bj < 2; ++bj) { unsigned char* blk = V8 + ((size_t)tile * 4 + (pn - 8) * 2 + bj) * 8192;
#pragma unroll
                    for (int n = 0; n < 2; ++n) { const int cofs = (((fr >> 2) ^ ((2 * fq + n) & 3)) << 4) + ((fr & 3) << 2);
#pragma unroll
                        for (int e = 0; e < 4; ++e) { const int dv = wc * 32 + 8 * fq + 4 * n + e;
                            int w = 0; w = __builtin_amdgcn_cvt_pk_fp8_f32(acc[ai][bj][0][n][e], acc[ai][bj][1][n][e], w, false); w = __builtin_amdgcn_cvt_pk_fp8_f32(acc[ai][bj][2][n][e], acc[ai][bj][3][n][e], w, true);
                            *(int*)(blk + dv * 64 + cofs) = w; } } } }
        }
    }
};
namespace att {
typedef short s16x4 __attribute__((ext_vector_type(4)));
constexpr int QBLK = 32, KVBLK = 64, LDQ = 512, LDK = 512;
#define KSWZ(row, colB) ((row) * 256 + ((colB) ^ (((row) & 7) << 4)))
#define SBAR() __builtin_amdgcn_sched_barrier(0)
__device__ __forceinline__ int crow(int r, int hi) { return (r & 3) + 8 * (r >> 2) + 4 * hi; }
__device__ __forceinline__ unsigned cvtpk_a(float lo, float hi) { unsigned r; asm volatile("v_cvt_pk_bf16_f32 %0, %1, %2" : "=v"(r) : "v"(lo), "v"(hi)); return r; }

typedef int v8i_t __attribute__((ext_vector_type(8)));
typedef short v2s_t __attribute__((ext_vector_type(2)));
__device__ __forceinline__ int krow_lds(int k) { return ((k & 4) << 3) + (k >> 4) + (((k >> 3) & 1) << 2) + ((k & 3) << 3); }
__device__ __forceinline__ int krow_key(int r) { return (((r >> 5) & 1) << 2) | ((r & 3) << 4) | (((r >> 2) & 1) << 3) | ((r >> 3) & 3); }
constexpr int SLOT = 16384, NS = 7, KOFF = 8192;
struct KFrag { u32x4 a0, a1, b0, b1; };
struct VFrag { u32x4 lo[4], hh[4]; };
__device__ __forceinline__ void k_read(KFrag& f, const char* S, int kofA, int kofB) {
  f.a0 = *reinterpret_cast<const u32x4*>(S + KOFF + kofA); f.a1 = *reinterpret_cast<const u32x4*>(S + KOFF + kofB);
  f.b0 = *reinterpret_cast<const u32x4*>(S + KOFF + 4096 + kofA); f.b1 = *reinterpret_cast<const u32x4*>(S + KOFF + 4096 + kofB);
}
__device__ __forceinline__ void v_read(VFrag& f, const char* S, int vofA, int vofB) {
#pragma unroll
  for (int d0 = 0; d0 < 4; ++d0) { f.lo[d0] = *reinterpret_cast<const u32x4*>(S + d0 * 2048 + vofA); f.hh[d0] = *reinterpret_cast<const u32x4*>(S + d0 * 2048 + vofB); }
}
__device__ __forceinline__ void qk_mma(f32x16& p0, f32x16& p1, const KFrag& f, const v8i_t& qr) {
  const v8i_t ka = {(int)f.a0.x, (int)f.a0.y, (int)f.a0.z, (int)f.a0.w, (int)f.a1.x, (int)f.a1.y, (int)f.a1.z, (int)f.a1.w};
  const v8i_t kb = {(int)f.b0.x, (int)f.b0.y, (int)f.b0.z, (int)f.b0.w, (int)f.b1.x, (int)f.b1.y, (int)f.b1.z, (int)f.b1.w};
  p0 = __builtin_amdgcn_mfma_scale_f32_32x32x64_f8f6f4(ka, qr, f32x16{}, 0, 0, 0, 0, 0, 0);
  p1 = __builtin_amdgcn_mfma_scale_f32_32x32x64_f8f6f4(kb, qr, f32x16{}, 0, 0, 0, 0, 0, 0);
}
__device__ __forceinline__ void pv_mma(f32x16* o, const VFrag& f, const v8i_t& pa) {
#pragma unroll
  for (int d0 = 0; d0 < 4; ++d0) {
    const v8i_t vb = {(int)f.lo[d0].x, (int)f.lo[d0].y, (int)f.lo[d0].z, (int)f.lo[d0].w, (int)f.hh[d0].x, (int)f.hh[d0].y, (int)f.hh[d0].z, (int)f.hh[d0].w};
    o[d0] = __builtin_amdgcn_mfma_scale_f32_32x32x64_f8f6f4(pa, vb, o[d0], 0, 0, 0, 0, 0, 0); }
}
__device__ __forceinline__ void soft_exp(f32x16& p) {
#pragma unroll
  for (int r = 0; r < 16; ++r) p[r] = __builtin_amdgcn_exp2f(p[r]);
}
__device__ __forceinline__ void soft_sum(const f32x16& p0, const f32x16& p1, float& l_reg) {
  float ps = p0[0];
#pragma unroll
  for (int r = 1; r < 16; ++r) ps += p0[r];
#pragma unroll
  for (int r = 0; r < 16; ++r) ps += p1[r];
  l_reg += ps;
}
template <int W0> __device__ __forceinline__ void soft_pack(const f32x16& p, float sc, v8i_t& pa) {
#pragma unroll
  for (int v = 0; v < 4; ++v) { v2s_t w = __builtin_bit_cast(v2s_t, pa[W0 + v]);
    w = __builtin_amdgcn_cvt_scalef32_pk_fp8_f32(w, p[4 * v], p[4 * v + 1], sc, false); w = __builtin_amdgcn_cvt_scalef32_pk_fp8_f32(w, p[4 * v + 2], p[4 * v + 3], sc, true); pa[W0 + v] = __builtin_bit_cast(int, w); }
}

__device__ __forceinline__ void attn_unit(const unsigned char* __restrict__ Q8b, const unsigned char* __restrict__ K8h, const unsigned char* __restrict__ V8h, bf16_t* __restrict__ Ob, int ldo,
                                          int seq, const float* __restrict__ subg, float lam, float psc, LAS unsigned char* ldsl) {
  char* lds = (char*)ldsl;
  int tid = threadIdx.x; asm volatile("" : "+v"(tid));
  const int wid = __builtin_amdgcn_readfirstlane(tid >> 6), lane = tid & 63, r32 = lane & 31, hi = lane >> 5;
  const int map = wid >> 2, qs = wid & 3, mapcol = map * 64;
  f32x16 o[4] = {}; v8i_t qr;
  asm volatile("s_waitcnt vmcnt(0)" ::: "memory");
  { const unsigned char* Qw = Q8b + (long)(qs * QBLK + r32) * 512 + mapcol + hi * 32;
    const u32x4 q0 = *reinterpret_cast<const u32x4*>(Qw), q1 = *reinterpret_cast<const u32x4*>(Qw + 16);
    qr = v8i_t{(int)q0.x, (int)q0.y, (int)q0.z, (int)q0.w, (int)q1.x, (int)q1.y, (int)q1.z, (int)q1.w}; }
  asm volatile("s_waitcnt vmcnt(0)" ::: "memory");
  const int kofA = r32 * 128 + (((map * 4 + 2 * hi) ^ ((r32 >> 1) & 7)) << 4), kofB = r32 * 128 + (((map * 4 + 2 * hi + 1) ^ ((r32 >> 1) & 7)) << 4);
  const int vofA = r32 * 64 + (((2 * hi) ^ ((r32 >> 2) & 3)) << 4), vofB = r32 * 64 + (((2 * hi + 1) ^ ((r32 >> 2) & 3)) << 4);
  const unsigned vsrc = (unsigned)tid * 16u, ksrc = (unsigned)(krow_key(tid >> 3) * 512 + (((tid & 7) ^ ((tid >> 4) & 7)) << 4));
  LAS unsigned char* const lw = ldsl + wid * 1024;
#define DMA(tl, sb) do { const int tl_ = (tl) < NT ? (tl) : NT - 1;        \
    __builtin_amdgcn_global_load_lds((const unsigned*)(V8h + (size_t)tl_ * 32768 + vsrc), (LAS unsigned*)(lw + (sb)), 16, 0, 0); \
    __builtin_amdgcn_global_load_lds((const unsigned*)(K8h + (size_t)tl_ * 32768 + ksrc), (LAS unsigned*)(lw + (sb) + KOFF), 16, 0, 0); } while (0)
#define NEXT(x) do { x += SLOT; if (x == NS * SLOT) x = 0; } while (0)
#define TBAR() do { asm volatile("s_waitcnt vmcnt(4)" ::: "memory"); __builtin_amdgcn_s_barrier(); } while (0)
#define H1(tl, S0, S1, WITHV) do { DMA((tl) + 4, dsl); NEXT(dsl); k_read(kf, lds + ksl, kofA, kofB); NEXT(ksl); if (WITHV) { v_read(vf, lds + vsl, vofA, vofB); NEXT(vsl); } \
    soft_exp(S0); soft_exp(S1); SBAR(); TBAR(); SBAR(); } while (0)
#define H2(S0, S1, N0, N1, PC, PP, WITHPV) do { qk_mma(N0, N1, kf, qr); if (WITHPV) { pv_mma(o, vf, PP); lacc = __builtin_amdgcn_mfma_scale_f32_32x32x64_f8f6f4(PP, ones, lacc, 0, 0, 0, 0, 0, 0); } soft_pack<0>(S0, psc, PC); soft_pack<4>(S1, psc, PC); SBAR(); TBAR(); } while (0)
  f32x16 sA0, sA1, sB0, sB1, lacc = {}; v8i_t pa0 = {}, pa1 = {}; KFrag kf; VFrag vf; const int NT = seq / KVBLK;
  const v8i_t ones = {0x38383838, 0x38383838, 0x38383838, 0x38383838, 0x38383838, 0x38383838, 0x38383838, 0x38383838};
  DMA(0, 0); DMA(1, SLOT); DMA(2, 2 * SLOT); DMA(3, 3 * SLOT);
  TBAR();
  int dsl = 4 * SLOT, ksl = SLOT, vsl = 0;
  k_read(kf, lds, kofA, kofB); qk_mma(sA0, sA1, kf, qr);
  if (map == 1) TBAR();
  H1(0, sA0, sA1, false); H2(sA0, sA1, sB0, sB1, pa0, pa1, false);
  for (int t = 1; t + 1 < NT; t += 2) {
    H1(t, sB0, sB1, true); H2(sB0, sB1, sA0, sA1, pa1, pa0, true);
    H1(t + 1, sA0, sA1, true); H2(sA0, sA1, sB0, sB1, pa0, pa1, true);
  }
  v_read(vf, lds + vsl, vofA, vofB); NEXT(vsl); soft_exp(sB0); soft_exp(sB1);
  SBAR(); pv_mma(o, vf, pa0); lacc = __builtin_amdgcn_mfma_scale_f32_32x32x64_f8f6f4(pa0, ones, lacc, 0, 0, 0, 0, 0, 0); soft_pack<0>(sB0, psc, pa1); soft_pack<4>(sB1, psc, pa1);
  SBAR(); v_read(vf, lds + vsl, vofA, vofB);
  SBAR(); pv_mma(o, vf, pa1); lacc = __builtin_amdgcn_mfma_scale_f32_32x32x64_f8f6f4(pa1, ones, lacc, 0, 0, 0, 0, 0, 0);
  if (map == 0) TBAR();
#undef DMA
#undef NEXT
#undef TBAR
#undef H1
#undef H2
  asm volatile("s_waitcnt vmcnt(0)" ::: "memory");
  __syncthreads();
  float* X = (float*)lds;
  int r32e = r32, hie = hi, qse = qs;
  asm volatile("" : "+v"(r32e), "+v"(hie), "+v"(qse));
  float rli[16];
#pragma unroll
  for (int r = 0; r < 16; ++r) rli[r] = __builtin_amdgcn_rcpf(lacc[r]) * (map ? -lam : 1.f);
  if (map == 1) {
#pragma unroll
    for (int r = 0; r < 16; ++r)
#pragma unroll
      for (int d0 = 0; d0 < 4; ++d0) X[(qse * 32 + crow(r, hie)) * 128 + d0 * 32 + r32e] = o[d0][r] * rli[r];
  }
  __syncthreads();
  if (map == 0) {
    float g4[4];
#pragma unroll
    for (int d0 = 0; d0 < 4; ++d0) g4[d0] = subg[d0 * 32 + r32e] * 0.8f;
#pragma unroll
    for (int r = 0; r < 16; ++r) { const int row = qse * 32 + crow(r, hie); float v[4]; float ss = 0.f;
#pragma unroll
      for (int d0 = 0; d0 < 4; ++d0) { v[d0] = o[d0][r] * rli[r] + X[row * 128 + d0 * 32 + r32e]; ss += v[d0] * v[d0]; }
      ss = half_sum32(ss);
      const float rs = rsqrtf(ss * (1.f / 128.f) + EPS);
#pragma unroll
      for (int d0 = 0; d0 < 4; ++d0) { const float y = v[d0] * rs * g4[d0]; Ob[(long)row * ldo + d0 * 32 + r32e] = (bf16_t)(cvtpk(y, y) & 0xffffu); } }
  }
  __syncthreads();
}
#undef KSWZ
#undef SBAR
}

__device__ __forceinline__ void conv_phase(const Frame& F, const Args& a, const bf16_t* HH, bf16_t* MIX, int row0, int nrows) {
    const int c = F.tid;
    float w[31];
#pragma unroll
    for (int j = 0; j < 31; ++j) w[j] = a.in[IN_CONVW][j * 512 + c];
    const float cb = a.in[IN_CONVB][c], lg = a.in[IN_CLNG][c], lb = a.in[IN_CLNB][c];
    LAS bf16_t* xs = (LAS bf16_t*)F.lds;
    LAS float* part = (LAS float*)(F.lds + 46 * 1024);
    LAS float* stat = part + 8 * 32;
    const int ntiles = nrows / 16;
    u32x4 pf[6];
#define CONV_FETCH(tt) do { const int r0_ = (tt) * 16; const int p_ = (row0 + r0_) % ROWS; \
        const int lo_ = (p_ < CTX) ? (r0_ - p_) : (r0_ - p_ + CTX), hi_ = (p_ < CTX) ? (r0_ - p_ + CTX) : (r0_ - p_ + ROWS); \
        _Pragma("unroll") for (int k_ = 0; k_ < 6; ++k_) { const int ch_ = F.tid + NTHR * k_; const int q_ = ch_ >> 6, cc_ = (ch_ & 63) * 8; const int rq_ = r0_ - 15 + q_; \
            u32x4 v_ = {0u, 0u, 0u, 0u}; if (ch_ < 46 * 64 && rq_ >= lo_ && rq_ < hi_) v_ = *(const u32x4*)(HH + (size_t)rq_ * 512 + cc_); pf[k_] = v_; } } while (0)
    if (F.bid < ntiles) CONV_FETCH(F.bid);
    for (int t = F.bid; t < ntiles; t += F.G) {
        const int r0 = t * 16;
        __syncthreads();
#pragma unroll
        for (int k = 0; k < 6; ++k) { const int ch = F.tid + NTHR * k; if (ch < 46 * 64) *(LAS u32x4*)(xs + (ch >> 6) * 512 + (ch & 63) * 8) = pf[k]; }
        __syncthreads();
        if (t + F.G < ntiles) CONV_FETCH(t + F.G);
        float out[16];
#pragma unroll
        for (int i = 0; i < 16; ++i) out[i] = cb;
#pragma unroll
        for (int q = 0; q < 46; ++q) { const float x = bf2f(xs[q * 512 + c]);
#pragma unroll
            for (int i = 0; i < 16; ++i) { const int j = q - i; if (j >= 0 && j <= 30) out[i] += x * w[j]; } }
#pragma unroll
        for (int i = 0; i < 16; ++i) { const float s1 = wave_sum(out[i]), s2 = wave_sum(out[i] * out[i]);
            if (F.lane == 0) { part[F.wave * 32 + i] = s1; part[F.wave * 32 + 16 + i] = s2; } }
        __syncthreads();
        if (F.tid < 32) { float s = 0.f;
#pragma unroll
            for (int wv = 0; wv < 8; ++wv) s += part[wv * 32 + F.tid];
            stat[F.tid] = s; }
        __syncthreads();
#pragma unroll
        for (int i = 0; i < 16; ++i) { const float mean = stat[i] * (1.f / 512.f); const float var = stat[16 + i] * (1.f / 512.f) - mean * mean;
            const float y = (out[i] - mean) * rsqrtf(fmaxf(var, 0.f) + EPS) * lg + lb; const float z = y * fsigmoid(y);
            MIX[(size_t)(r0 + i) * 1024 + c] = (bf16_t)(cvtpk(z, z) & 0xffffu); }
    }
#undef CONV_FETCH
    __syncthreads();
}

__device__ __forceinline__ void attn_phase(const Frame& F, const Args& a, const unsigned char* Q8, const unsigned char* K8, const unsigned char* V8, bf16_t* MIX, int nrows) {
    const int nb = nrows / ROWS; const float lam = ((const float*)(a.ws + FW_SCAL))[0]; const float psc = ((const float*)(a.ws + FW_SCAL))[1];
    const int nlat = nb * 512, nctx = nb * 8;
#ifndef MK_ATTX
#define MK_ATTX 1
#endif
    for (int L0 = F.bid; L0 < (nlat + nctx) * MK_ATTX; L0 += F.G) { const int L = L0 % (nlat + nctx);
        int b, h, q0, seq;
        if (L < nlat) { b = L / 512; const int r = L % 512; h = r >> 7; q0 = CTX + (r & 127) * 128; seq = ROWS; }
        else { const int r = L - nlat; b = r >> 3; h = (r >> 1) & 3; q0 = (r & 1) * 128; seq = CTX; }
        const size_t rb = (size_t)b * ROWS;
        att::attn_unit(Q8 + (rb + q0) * 512 + h * 128, K8 + rb * 512 + h * 128, V8 + ((size_t)b * (ROWS / 64) * 4 + h) * 8192, MIX + (rb + q0) * 1024 + 512 + h * 128, 1024, seq, a.in[IN_SUBLN], lam, psc, F.lds);
    }
}

template <class TIN> struct EpiResid2 {
    static constexpr bool PERM = true;
    const TIN *Hl_in, *Hc_in; bf16_t *Hl_out, *Hc_out; const float* mods_l; int gate_idx; int rowbase;
    __device__ __forceinline__ void operator()(const f32x4 (&acc)[2][2][4][2], const pg8::Unit& u, int wr, int wc, int fr, int fq) const {
        asm volatile("" : "+v"(fr), "+v"(fq));
        const int rg0 = rowbase + u.pm * 256; const int b = rg0 / ROWS, p0 = rg0 % ROWS; const bool isctx = p0 < CTX;
        const TIN* hin = isctx ? Hc_in + (size_t)(b * CTX + p0) * D : Hl_in + (size_t)(b * SEQ + (p0 - CTX)) * D;
        bf16_t* hout = isctx ? Hc_out + (size_t)(b * CTX + p0) * D : Hl_out + (size_t)(b * SEQ + (p0 - CTX)) * D;
        const float* gate = mods_l + (size_t)(isctx ? 2 : b) * 6144 + gate_idx * 1024;
        const int col0 = u.pn * 256 + wc * 32 + 8 * fq;
#pragma unroll
        for (int bj = 0; bj < 2; ++bj) { const int col = col0 + bj * 128; const f32x4 g0 = *(const f32x4*)(gate + col), g1 = *(const f32x4*)(gate + col + 4);
#pragma unroll
            for (int ai = 0; ai < 2; ++ai) { f32x4 h0[4], h1[4];
#pragma unroll
                for (int m = 0; m < 4; ++m) { const size_t off = (size_t)(ai * 128 + wr * 64 + m * 16 + fr) * D + col;
                    if constexpr (sizeof(TIN) == 4) { h0[m] = *(const f32x4*)((const float*)hin + off); h1[m] = *(const f32x4*)((const float*)hin + off + 4); }
                    else { const u32x4 w = *(const u32x4*)((const bf16_t*)hin + off);
                        h0[m] = (f32x4){__uint_as_float(w.x << 16), __uint_as_float(w.x & 0xffff0000u), __uint_as_float(w.y << 16), __uint_as_float(w.y & 0xffff0000u)};
                        h1[m] = (f32x4){__uint_as_float(w.z << 16), __uint_as_float(w.z & 0xffff0000u), __uint_as_float(w.w << 16), __uint_as_float(w.w & 0xffff0000u)}; } }
#pragma unroll
                for (int m = 0; m < 4; ++m) { const size_t off = (size_t)(ai * 128 + wr * 64 + m * 16 + fr) * D + col;
                    const f32x4 y0 = h0[m] + g0 * acc[ai][bj][m][0], y1 = h1[m] + g1 * acc[ai][bj][m][1];
                    u32x4 w; w.x = cvtpk(y0.x, y0.y); w.y = cvtpk(y0.z, y0.w); w.z = cvtpk(y1.x, y1.y); w.w = cvtpk(y1.z, y1.w);
                    *(u32x4*)(hout + off) = w; } } }
    }
};
struct MoeBufs {
    int* cnt;
    int* tok;
    int* slot;
    float* gate;
    bf16_t* HB;
    bf16_t* YS;
    int cap, pad;
};
struct SrcW13 { __device__ __forceinline__ int operator()(int j) const { const int pn = j >> 8, jl = j & 255; return 128 * pn + (jl & 127); } };

__device__ __forceinline__ void wmoe_item(const Args& a, int l, bf16_t* W13t, bf16_t* W2t, int it, LAS float* scr, int lane) {
    const float* w1 = a.in[IN_W1] + (size_t)l * 32 * 1024 * 512; const float* w3 = a.in[IN_W3] + (size_t)l * 32 * 1024 * 512; const float* w2 = a.in[IN_W2] + (size_t)l * 32 * 512 * 1024;
    const int e = it / 384, r = it % 384;
    if (r < 256) { const int h = r >> 7, kb = (r >> 3) & 15, mblk = r & 7;
        const int j0 = (mblk >> 1) * 256 + h * 128 + (mblk & 1) * 64;
        conv_item((h ? w3 : w1) + (size_t)e * 1024 * 512, 512, W13t + (size_t)e * 1024 * 1024, 1024, kb * 64, j0, SrcW13{}, scr, lane); }
    else { const int r2 = r - 256, kb = r2 >> 4, nb = r2 & 15;
        conv_item(w2 + (size_t)e * 512 * 1024, 1024, W2t + (size_t)e * 1024 * 512, 512, kb * 64, nb * 64, SrcIdent{}, scr, lane); }
}
constexpr int WMOE_ITEMS = 32 * 384;
__device__ __forceinline__ void phase_wmoe(const Frame& F, const Args& a, int l, bf16_t* W13t, bf16_t* W2t, int bid0 = 0, int nbid = 0, int it_lo = 0, int it_hi = WMOE_ITEMS) {
    LAS float* scr = (LAS float*)(F.lds + F.wave * 16640);
    const int gw = (F.bid - bid0) * NWAVES + F.wave, NGW = (nbid ? nbid : F.G) * NWAVES;
    for (int it = it_lo + gw; it < it_hi; it += NGW) wmoe_item(a, l, W13t, W2t, it, scr, F.lane);
}
__device__ __forceinline__ void drain_wmoe(const Frame& F, const Args& a, int l, bf16_t* W13t, bf16_t* W2t, unsigned* counter) {
    __syncthreads();
    LAS float* scr = (LAS float*)(F.lds + F.wave * 16640);
    for (;;) { unsigned it = 0; if (F.lane == 0) it = atomicAdd(counter, 1u); it = (unsigned)__builtin_amdgcn_readfirstlane((int)it);
        if (it >= (unsigned)WMOE_ITEMS) break; wmoe_item(a, l, W13t, W2t, (int)it, scr, F.lane); }
    __syncthreads();
}

struct HRows { bf16_t* Hl; bf16_t* Hc;
    __device__ __forceinline__ bf16_t* row(int rg) const { const int b = rg / ROWS, p = rg % ROWS; return p < CTX ? Hc + (size_t)(b * CTX + p) * D : Hl + (size_t)(b * SEQ + (p - CTX)) * D; } };
__device__ __forceinline__ f32x4 bf4(u32x2 w) { return (f32x4){__uint_as_float(w.x << 16), __uint_as_float(w.x & 0xffff0000u), __uint_as_float(w.y << 16), __uint_as_float(w.y & 0xffff0000u)}; }

constexpr int RT_XS = 1032;
constexpr int RT_PART = 66048, RT_LGT = RT_PART + 8 * 16 * 48 * 4, RT_DEC = RT_LGT + 2 * 16 * 40 * 4 + 512;
constexpr int RT_CNT = RT_DEC + 4 * 4096, RT_BASE = RT_CNT + 128, RT_PSUM = RT_BASE + 128;
__device__ __forceinline__ void phase_route(const Frame& F, const Args& a, int l, const HRows& H, bf16_t* N, const MoeBufs& mb, int row0, int nrows, bool latent_only, int* cntW) {
    constexpr int RW = 2, RB = 8 * RW;
    const float* mods = (const float*)(a.ws + FW_MODS) + (size_t)l * 3 * 6144;
    const float* g2 = a.in[IN_N2G] + l * D;
    const float* rgw = a.in[IN_RGW] + (size_t)l * 1024 * 4; const float* rgb = a.in[IN_RGB] + l * 4;
    const float* rew = a.in[IN_REW] + (size_t)l * 1024 * 32; const float* reb = a.in[IN_REB] + l * 32;
    LAS bf16_t* xh = (LAS bf16_t*)F.lds;
    LAS bf16_t* xl = xh + 16 * RT_XS;
    LAS float* part = (LAS float*)(F.lds + RT_PART);
    LAS float* lgt = (LAS float*)(F.lds + RT_LGT);
    bf16x8 wh[4][3], wl[4][3];
    { const int c = F.lane & 15, g = F.lane >> 4;
#pragma unroll
      for (int ks = 0; ks < 4; ++ks)
#pragma unroll
        for (int cb = 0; cb < 3; ++cb) { unsigned hw[4], lw[4];
#pragma unroll
            for (int e2 = 0; e2 < 4; ++e2) { float wv[2];
#pragma unroll
                for (int q = 0; q < 2; ++q) { const int k = 128 * F.wave + 32 * ks + 8 * g + 2 * e2 + q; wv[q] = (cb < 2) ? rew[k * 32 + 16 * cb + c] : ((c < 4) ? rgw[k * 4 + c] : 0.f); }
                hw[e2] = cvtpk(wv[0], wv[1]); lw[e2] = cvtpk(wv[0] - __uint_as_float(hw[e2] << 16), wv[1] - __uint_as_float(hw[e2] & 0xffff0000u)); }
            const u32x4 h4 = {hw[0], hw[1], hw[2], hw[3]}, l4 = {lw[0], lw[1], lw[2], lw[3]};
            wh[ks][cb] = *reinterpret_cast<const bf16x8*>(&h4); wl[ks][cb] = *reinterpret_cast<const bf16x8*>(&l4); } }
    const int nb = nrows / ROWS; const int neff = latent_only ? nb * SEQ : nrows;
    const int nit = (neff / RB + F.G - 1) / F.G;
    auto lrow = [&](int i_) -> int { return latent_only ? (i_ / SEQ) * ROWS + CTX + (i_ % SEQ) : i_; };
    u32x2 nv[RW][4];
#define RT_FETCH(it_) do { const int ib_ = ((it_) * F.G + F.bid) * RB; if ((it_) < nit && ib_ < neff) { _Pragma("unroll") for (int r_ = 0; r_ < RW; ++r_) { \
        const u32x2* hr_ = (const u32x2*)H.row(row0 + lrow(ib_ + F.wave * RW + r_)) + F.lane; _Pragma("unroll") for (int j_ = 0; j_ < 4; ++j_) nv[r_][j_] = hr_[64 * j_]; } } } while (0)
    RT_FETCH(0);
    LAS int* dec = (LAS int*)(F.lds + RT_DEC); LAS int* cntL = (LAS int*)(F.lds + RT_CNT);
    if (F.tid < 32) cntL[F.tid] = 0;
    int nact = 0;
#ifndef MK_ROUTEX
#define MK_ROUTEX 1
#endif
    for (int itx = 0; itx < nit * MK_ROUTEX; ++itx) { const int it = itx % nit;
        const int ib = (it * F.G + F.bid) * RB;
        const bool act = ib < neff;
        f32x4 v[RW][4];
#pragma unroll
        for (int r = 0; r < RW; ++r)
#pragma unroll
            for (int j = 0; j < 4; ++j) v[r][j] = bf4(nv[r][j]);
        RT_FETCH((itx + 1) % nit);
        if (act) {
#pragma unroll
            for (int r = 0; r < RW; ++r) { const int lr = lrow(ib + F.wave * RW + r); const int rg = row0 + lr, b = rg / ROWS, p = rg % ROWS;
                const float* m = mods + (size_t)(p < CTX ? 2 : b) * 6144;
                float ss = 0.f;
#pragma unroll
                for (int j = 0; j < 4; ++j) ss += (v[r][j].x * v[r][j].x + v[r][j].y * v[r][j].y) + (v[r][j].z * v[r][j].z + v[r][j].w * v[r][j].w);
                const float rs = rsqrtf(wave_sum(ss) * (1.f / D) + EPS);
                u32x2* o8 = (u32x2*)(N + (size_t)lr * D) + F.lane;
#pragma unroll
                for (int j = 0; j < 4; ++j) { const int c = 4 * F.lane + 256 * j; const f32x4 gg = *(const f32x4*)(g2 + c), sh = *(const f32x4*)(m + 3 * 1024 + c), sc = *(const f32x4*)(m + 4 * 1024 + c);
                    const f32x4 y = v[r][j] * rs * gg * (sc + 1.f) + sh; u32x2 w; w.x = cvtpk(y.x, y.y); w.y = cvtpk(y.z, y.w); o8[64 * j] = w;
                    u32x2 lo; lo.x = cvtpk(y.x - __uint_as_float(w.x << 16), y.y - __uint_as_float(w.x & 0xffff0000u)); lo.y = cvtpk(y.z - __uint_as_float(w.y << 16), y.w - __uint_as_float(w.y & 0xffff0000u));
                    *(LAS u32x2*)(xh + (F.wave * RW + r) * RT_XS + c) = w; *(LAS u32x2*)(xl + (F.wave * RW + r) * RT_XS + c) = lo; } }
        }
        __syncthreads();
        LAS float* lg = lgt + (it & 1) * RB * 40;
        if (act) {
            f32x4 acc0 = {0.f, 0.f, 0.f, 0.f}, acc1 = acc0, acc2 = acc0;
            const int xo = (F.lane & 15) * RT_XS + 128 * F.wave + 8 * (F.lane >> 4);
#pragma unroll
            for (int ks = 0; ks < 4; ++ks) { const bf16x8 ah = *(const LAS bf16x8*)(xh + xo + 32 * ks), al = *(const LAS bf16x8*)(xl + xo + 32 * ks);
                acc0 = __builtin_amdgcn_mfma_f32_16x16x32_bf16(ah, wh[ks][0], acc0, 0, 0, 0); acc1 = __builtin_amdgcn_mfma_f32_16x16x32_bf16(ah, wh[ks][1], acc1, 0, 0, 0); acc2 = __builtin_amdgcn_mfma_f32_16x16x32_bf16(ah, wh[ks][2], acc2, 0, 0, 0);
                acc0 = __builtin_amdgcn_mfma_f32_16x16x32_bf16(ah, wl[ks][0], acc0, 0, 0, 0); acc1 = __builtin_amdgcn_mfma_f32_16x16x32_bf16(ah, wl[ks][1], acc1, 0, 0, 0); acc2 = __builtin_amdgcn_mfma_f32_16x16x32_bf16(ah, wl[ks][2], acc2, 0, 0, 0);
                acc0 = __builtin_amdgcn_mfma_f32_16x16x32_bf16(al, wh[ks][0], acc0, 0, 0, 0); acc1 = __builtin_amdgcn_mfma_f32_16x16x32_bf16(al, wh[ks][1], acc1, 0, 0, 0); acc2 = __builtin_amdgcn_mfma_f32_16x16x32_bf16(al, wh[ks][2], acc2, 0, 0, 0); }
            LAS float* pw = part + F.wave * (16 * 48) + (4 * (F.lane >> 4)) * 48 + (F.lane & 15);
#pragma unroll
            for (int r = 0; r < 4; ++r) { pw[r * 48] = acc0[r]; pw[r * 48 + 16] = acc1[r]; pw[r * 48 + 32] = acc2[r]; }
        }
        __syncthreads();
        if (act) { const int row = F.tid >> 5, c = F.tid & 31; float s = 0.f, sg = 0.f;
#pragma unroll
            for (int w = 0; w < 8; ++w) { s += part[w * (16 * 48) + row * 48 + c]; if (c < 4) sg += part[w * (16 * 48) + row * 48 + 32 + c]; }
            lg[row * 40 + c] = s; if (c < 4) lg[row * 40 + 32 + c] = sg; }
        __syncthreads();
        if (act && F.tid < RB && itx < nit) { const LAS float* L = lg + F.tid * 40;
            const int row = lrow(ib + F.tid);
            const float lg0 = L[32] + rgb[0], lg1 = L[33] + rgb[1], lg2 = L[34] + rgb[2], lg3 = L[35] + rgb[3];
            int gi = 0; float bm = lg0;
            if (lg1 > bm) { bm = lg1; gi = 1; }
            if (lg2 > bm) { bm = lg2; gi = 2; }
            if (lg3 > bm) { bm = lg3; gi = 3; }
            const float pgs = 1.f / (expf(lg0 - bm) + expf(lg1 - bm) + expf(lg2 - bm) + expf(lg3 - bm));
            int i0 = 0; float v0 = L[gi * 8] + reb[gi * 8];
            for (int j = 1; j < 8; ++j) { const float x = L[gi * 8 + j] + reb[gi * 8 + j]; if (x > v0) { v0 = x; i0 = j; } }
            int i1 = -1; float v1 = -3.0e38f;
            for (int j = 0; j < 8; ++j) { const float x = L[gi * 8 + j] + reb[gi * 8 + j]; if (j != i0 && x > v1) { v1 = x; i1 = j; } }
            const float e1 = expf(v1 - v0); const float g0 = pgs / (1.f + e1), g1 = pgs * e1 / (1.f + e1);
            const int ea = gi * 8 + i0, eb = gi * 8 + i1; const int di = it * RB + F.tid;
            const int pa = __hip_atomic_fetch_add(&cntL[ea], 1, __ATOMIC_RELAXED, __HIP_MEMORY_SCOPE_WORKGROUP), pb = __hip_atomic_fetch_add(&cntL[eb], 1, __ATOMIC_RELAXED, __HIP_MEMORY_SCOPE_WORKGROUP);
            dec[di] = row; dec[1024 + di] = ea | (eb << 8); dec[2048 + di] = pa; dec[3072 + di] = pb;
            mb.gate[row * 2] = g0; mb.gate[row * 2 + 1] = g1;
        }
        if (act && itx < nit) nact = it + 1;
    }
    __syncthreads();
    if (F.tid < 32) cntW[F.bid * 32 + F.tid] = cntL[F.tid];
    if (F.tid == 0) ((LAS int*)(F.lds + RT_PSUM))[16 * 32] = nact * RB;
#undef RT_FETCH
    __syncthreads();
}

__device__ __forceinline__ void phase_route_scatter(const Frame& F, const MoeBufs& mb, const int* cntW) {
    LAS int* dec = (LAS int*)(F.lds + RT_DEC); LAS int* base = (LAS int*)(F.lds + RT_BASE); LAS int* psum = (LAS int*)(F.lds + RT_PSUM);
    const int e = F.tid & 31, part = F.tid >> 5, PS = (F.G + 15) / 16;
    { int s = 0, sb = 0; const int w0 = part * PS, w1 = (w0 + PS < F.G) ? w0 + PS : F.G;
      for (int w = w0; w < w1; ++w) { const int c = cntW[w * 32 + e]; if (w < F.bid) sb += c; s += c; }
      psum[part * 32 + e] = s; psum[17 * 32 + part * 32 + e] = sb; }
    __syncthreads();
    if (F.tid < 32) { int tot = 0, b = 0;
#pragma unroll
        for (int p = 0; p < 16; ++p) { tot += psum[p * 32 + F.tid]; b += psum[17 * 32 + p * 32 + F.tid]; }
        base[F.tid] = b; if (F.bid == 0) mb.cnt[F.tid] = tot; }
    __syncthreads();
    const int ndec = psum[16 * 32];
    for (int di = F.tid; di < ndec; di += NTHR) { const int row = dec[di], ee = dec[1024 + di], ea = ee & 255, eb = ee >> 8, pa = base[ea] + dec[2048 + di], pb = base[eb] + dec[3072 + di];
        mb.tok[(size_t)ea * mb.cap + pa] = row; mb.slot[(size_t)ea * mb.cap + pa] = row * 2;
        mb.tok[(size_t)eb * mb.cap + pb] = row; mb.slot[(size_t)eb * mb.cap + pb] = row * 2 + 1; }
    __syncthreads();
}

struct MoeOrder {
    int G, c, total; const LAS int* pre;
    __device__ __forceinline__ bool next(int i, pg8::Unit& u) const {
        const long L = (long)i * G + c; if (L >= (long)total * 4) return false;
        const int blk = (int)(L >> 2); int e = 0;
        while (pre[e + 1] <= blk) ++e;
        u.pm = blk; u.pn = (int)(L & 3); u.e = e; u.j = blk - pre[e]; return true;
    }
};
__device__ __forceinline__ int moe_order_init(const Frame& F, const int* cnt, LAS int* pre) {
    __syncthreads();
    if (F.tid == 0) { int s = 0; for (int e = 0; e < 32; ++e) { pre[e] = s; s += (cnt[e] + 255) >> 8; } pre[32] = s; }
    __syncthreads();
    return pre[32];
}
struct EpiSwiGLU {
    static constexpr bool PERM = true;
    bf16_t* HB;
    __device__ __forceinline__ void operator()(const f32x4 (&acc)[2][2][4][2], const pg8::Unit& u, int wr, int wc, int fr, int fq) const {
        asm volatile("" : "+v"(fr), "+v"(fq));
#pragma unroll
        for (int ai = 0; ai < 2; ++ai)
#pragma unroll
            for (int m = 0; m < 4; ++m) { const size_t row = (size_t)u.pm * 256 + ai * 128 + wr * 64 + m * 16 + fr;
                float h[8];
#pragma unroll
                for (int n = 0; n < 2; ++n)
#pragma unroll
                    for (int e = 0; e < 4; ++e) { const float x = acc[ai][0][m][n][e]; h[n * 4 + e] = x * fsigmoid(x) * acc[ai][1][m][n][e]; }
                u32x4 w; w.x = cvtpk(h[0], h[1]); w.y = cvtpk(h[2], h[3]); w.z = cvtpk(h[4], h[5]); w.w = cvtpk(h[6], h[7]);
                *(u32x4*)(HB + row * 512 + u.pn * 128 + wc * 32 + 8 * fq) = w; }
    }
};
struct EpiMoeDown2 {
    static constexpr bool PERM = true;
    bf16_t* YS; const int* slot; const float* gate; const int* cnt; int cap, pad;
    __device__ __forceinline__ void operator()(const f32x4 (&acc)[2][2][4][2], const pg8::Unit& u, int wr, int wc, int fr, int fq) const {
        asm volatile("" : "+v"(fr), "+v"(fq));
        const int n_e = cnt[u.e];
#pragma unroll
        for (int ai = 0; ai < 2; ++ai)
#pragma unroll
            for (int m = 0; m < 4; ++m) { const int pos = 256 * u.j + ai * 128 + wr * 64 + m * 16 + fr;
                if (pos < n_e) { const int sl = slot[(size_t)u.e * cap + pos]; const float gt = gate[sl];
#pragma unroll
                    for (int bj = 0; bj < 2; ++bj) { const f32x4 v0 = acc[ai][bj][m][0] * gt, v1 = acc[ai][bj][m][1] * gt;
                        u32x4 w; w.x = cvtpk(v0.x, v0.y); w.y = cvtpk(v0.z, v0.w); w.z = cvtpk(v1.x, v1.y); w.w = cvtpk(v1.z, v1.w);
                        *(u32x4*)(YS + (size_t)sl * 1024 + u.pn * 256 + bj * 128 + wc * 32 + 8 * fq) = w; } } }
    }
};
__device__ __forceinline__ void phase_moe_up(const Frame& F, const bf16_t* N, const bf16_t* W13t, const MoeBufs& mb) {
    LAS int* pre = (LAS int*)(F.lds + pg8::STAGE_BYTES);
    const int total = moe_order_init(F, mb.cnt, pre);
    pg8::Gemm g{N, W13t, 1024, (long)1024 * 1024, mb.tok, mb.cnt, mb.cap};
    MoeOrder S{F.G, F.bid, total, pre};
    EpiSwiGLU E{mb.HB};
    pg8::gemm_phase<true>(F.lds, g, S, E);
}
__device__ __forceinline__ void phase_moe_down(const Frame& F, const bf16_t* W2t, const MoeBufs& mb) {
    LAS int* pre = (LAS int*)(F.lds + pg8::STAGE_BYTES);
    const int total = moe_order_init(F, mb.cnt, pre);
    pg8::Gemm g{mb.HB, W2t, 512, (long)1024 * 512, nullptr, nullptr, 0};
    MoeOrder S{F.G, F.bid, total, pre};
    EpiMoeDown2 E{mb.YS, mb.slot, mb.gate, mb.cnt, mb.cap, 0};
    pg8::gemm_phase<false>(F.lds, g, S, E);
}
template <bool FINAL> __device__ __forceinline__ void phase_combine(const Frame& F, const Args& a, int l, const HRows& H, const bf16_t* YS, bf16_t* N, float* OUT, int row0, int nrows, bool latent_only) {
    const float* mods = (const float*)(a.ws + FW_MODS) + (size_t)l * 3 * 6144;
    const float* modsn = (const float*)(a.ws + FW_MODS) + (size_t)(l + 1) * 3 * 6144;
    const float* g1n = a.in[IN_N1G] + (l + 1) * D;
    const int gw = F.bid * NWAVES + F.wave, NGW = F.G * NWAVES;
    const int nb = nrows / ROWS; const int neff = latent_only ? nb * SEQ : nrows;
    for (int i = gw; i < neff; i += NGW) {
        const int lr = latent_only ? (i / SEQ) * ROWS + CTX + (i % SEQ) : i;
        const int rg = row0 + lr, b = rg / ROWS, p = rg % ROWS; const int mr = p < CTX ? 2 : b;
        const float* gt = mods + (size_t)mr * 6144 + 5 * 1024;
        u32x2* hr = (u32x2*)H.row(rg) + F.lane;
        const u32x2* y0 = (const u32x2*)(YS + (size_t)(lr * 2) * 1024) + F.lane; const u32x2* y1 = (const u32x2*)(YS + (size_t)(lr * 2 + 1) * 1024) + F.lane;
        u32x2 hw[4], a0[4], a1[4];
#pragma unroll
        for (int j = 0; j < 4; ++j) { hw[j] = hr[64 * j]; a0[j] = y0[64 * j]; a1[j] = y1[64 * j]; }
        f32x4 v[4]; float ss = 0.f;
#pragma unroll
        for (int j = 0; j < 4; ++j) { const int c = 4 * F.lane + 256 * j; const f32x4 g = *(const f32x4*)(gt + c);
            v[j] = bf4(hw[j]) + g * (bf4(a0[j]) + bf4(a1[j]));
            if constexpr (FINAL) { *((f32x4*)(OUT + ((size_t)(b * SEQ + (p - CTX))) * D) + F.lane + 64 * j) = v[j]; }
            else { u32x2 w; w.x = cvtpk(v[j].x, v[j].y); w.y = cvtpk(v[j].z, v[j].w); hr[64 * j] = w;
                   v[j] = bf4(w);
                   ss += (v[j].x * v[j].x + v[j].y * v[j].y) + (v[j].z * v[j].z + v[j].w * v[j].w); } }
        if constexpr (!FINAL) { const float rs = rsqrtf(wave_sum(ss) * (1.f / D) + EPS); const float* m = modsn + (size_t)mr * 6144;
            u32x2* o8 = (u32x2*)(N + (size_t)lr * D) + F.lane;
#pragma unroll
            for (int j = 0; j < 4; ++j) { const int c = 4 * F.lane + 256 * j; const f32x4 gg = *(const f32x4*)(g1n + c), sh = *(const f32x4*)(m + c), sc = *(const f32x4*)(m + 1024 + c);
                const f32x4 y = v[j] * rs * gg * (sc + 1.f) + sh; u32x2 w; w.x = cvtpk(y.x, y.y); w.y = cvtpk(y.z, y.w); o8[64 * j] = w; } }
    }
}
struct GlaBufs {
    bf16_t *Qg, *Kg;
    bf16_t *Vg, *Gg;
    float* A1;
    bf16_t *QD, *KXT, *ATT;
    float* GD;
    bf16_t *OF, *OB;
    float *ES, *DS;
};
struct EpiInL1 {
    static constexpr bool PERM = true;
    GlaBufs gb;
    __device__ __forceinline__ void operator()(const f32x4 (&acc)[2][2][4][2], const pg8::Unit& u, int wr, int wc, int fr, int fq) const {
        asm volatile("" : "+v"(fr), "+v"(fq));
        const int pn = u.pn;
        if (pn < 12) {
            bf16_t* dst; int ld, c0; float sc = 1.f;
            if (pn < 2) { dst = gb.Qg; ld = 512; c0 = pn * 256; sc = 0.08838834764831845f; }
            else if (pn < 4) { dst = gb.Kg; ld = 512; c0 = (pn - 2) * 256; }
            else if (pn < 8) { dst = gb.Vg; ld = 1024; c0 = (pn - 4) * 256; }
            else { dst = gb.Gg; ld = 1024; c0 = (pn - 8) * 256; }
#pragma unroll
            for (int ai = 0; ai < 2; ++ai)
#pragma unroll
                for (int m = 0; m < 4; ++m) { const size_t row = (size_t)u.pm * 256 + ai * 128 + wr * 64 + m * 16 + fr;
#pragma unroll
                    for (int bj = 0; bj < 2; ++bj) { f32x4 v0 = acc[ai][bj][m][0] * sc, v1 = acc[ai][bj][m][1] * sc;
                        u32x4 w; w.x = cvtpk(v0.x, v0.y); w.y = cvtpk(v0.z, v0.w); w.z = cvtpk(v1.x, v1.y); w.w = cvtpk(v1.z, v1.w);
                        *(u32x4*)(dst + row * ld + c0 + bj * 128 + wc * 32 + 8 * fq) = w; } }
        } else if (wc == 0) {
#pragma unroll
            for (int ai = 0; ai < 2; ++ai)
#pragma unroll
                for (int m = 0; m < 4; ++m) { const size_t row = (size_t)u.pm * 256 + ai * 128 + wr * 64 + m * 16 + fr;
                    *(f32x4*)(gb.A1 + row * 32 + 8 * fq) = acc[ai][0][m][0]; *(f32x4*)(gb.A1 + row * 32 + 8 * fq + 4) = acc[ai][0][m][1]; }
        }
    }
};

namespace gla {
constexpr int NCH = ROWS / 64;
__device__ __forceinline__ int chunk_base(int dir, int c) { return dir == 0 ? 64 * c : (c < 4 ? 192 - 64 * c : 16576 - 64 * (c - 4)); }
__device__ __forceinline__ int crow(int r, int hi) { return (r & 3) + 8 * (r >> 2) + 4 * hi; }
typedef short s16x4 __attribute__((ext_vector_type(4)));

__device__ __forceinline__ void prep_phase(const Frame& F, const Args& a, const GlaBufs& gb, int nrows) {
    const int nb = nrows / ROWS, nitems = nb * 8 * NCH;
    const float* w_a2 = a.in[IN_GLAWA2]; const float* b_a2 = a.in[IN_GLABA2];
    LAS float* a1s = (LAS float*)F.lds;
    LAS float* gsum = a1s + 64 * 16;
    LAS bf16_t* qds = (LAS bf16_t*)(F.lds + 8192);
    LAS bf16_t* kxs = qds + 64 * 136;
    const int d = F.tid & 127, ig = F.tid >> 7, r32 = F.lane & 31, hi = F.lane >> 5;
    u32x4 fq[2], fk[2]; f32x4 fa = {0.f, 0.f, 0.f, 0.f};
#define PREP_FETCH(itn) do { const int c_ = (itn) % NCH; int rr_ = (itn) / NCH; const int dir_ = rr_ & 1; rr_ >>= 1; const int h_ = rr_ & 3; const int b_ = rr_ >> 2; \
        const int lb_ = b_ * ROWS, base_ = chunk_base(dir_, c_); \
        if (F.tid < 256) { const int i_ = F.tid >> 2, q4_ = F.tid & 3; const int row_ = lb_ + (dir_ ? base_ + 63 - i_ : base_ + i_); fa = *(const f32x4*)(gb.A1 + (size_t)row_ * 32 + dir_ * 16 + q4_ * 4); } \
        _Pragma("unroll") for (int u_ = 0; u_ < 2; ++u_) { const int ch_ = F.tid + 512 * u_, i_ = ch_ >> 4, cc_ = ch_ & 15; const size_t row_ = (size_t)lb_ + (dir_ ? base_ + 63 - i_ : base_ + i_); \
            fq[u_] = *(const u32x4*)(gb.Qg + row_ * 512 + h_ * 128 + cc_ * 8); fk[u_] = *(const u32x4*)(gb.Kg + row_ * 512 + h_ * 128 + cc_ * 8); } } while (0)
    if (F.bid < nitems) PREP_FETCH(F.bid);
    for (int it = F.bid; it < nitems; it += F.G) {
        const int c = it % NCH; int rr = it / NCH; const int dir = rr & 1; rr >>= 1; const int h = rr & 3; const int b = rr >> 2;
        const int lb = b * ROWS, base = chunk_base(dir, c);
        __syncthreads();
        if (F.tid < 256) { const int i = F.tid >> 2, q4 = F.tid & 3; *(LAS f32x4*)(a1s + i * 16 + q4 * 4) = fa; }
#pragma unroll
        for (int u = 0; u < 2; ++u) { const int ch = F.tid + 512 * u, i = ch >> 4, cc = ch & 15;
            *(LAS u32x4*)(qds + i * 136 + cc * 8) = fq[u]; *(LAS u32x4*)(kxs + i * 136 + cc * 8) = fk[u]; }
        if (it + F.G < nitems) PREP_FETCH(it + F.G);
        float w2[16];
#pragma unroll
        for (int r = 0; r < 16; ++r) w2[r] = w_a2[(dir * 16 + r) * 512 + h * 128 + d];
        const float bb = b_a2[dir * 512 + h * 128 + d];
        __syncthreads();
        float bl[16]; float run = 0.f;
#pragma unroll
        for (int ii = 0; ii < 16; ++ii) { const int i = ig * 16 + ii; float z = bb;
#pragma unroll
            for (int r4 = 0; r4 < 4; ++r4) { const f32x4 av = *(const LAS f32x4*)(a1s + i * 16 + 4 * r4); z += av.x * w2[4 * r4] + av.y * w2[4 * r4 + 1] + av.z * w2[4 * r4 + 2] + av.w * w2[4 * r4 + 3]; }
            const float la = (fminf(z, 0.f) - 0.6931471805599453f * __builtin_amdgcn_logf(1.f + __builtin_amdgcn_exp2f(-fabsf(z) * LOG2E))) * (1.f / 16.f); run += la; bl[ii] = run; }
        gsum[ig * 128 + d] = run;
        __syncthreads();
        float pre = 0.f, tot = 0.f;
#pragma unroll
        for (int g = 0; g < 4; ++g) { const float v = gsum[g * 128 + d]; pre += (g < ig) ? v : 0.f; tot += v; }
#pragma unroll
        for (int ii = 0; ii < 16; ++ii) { const int i = ig * 16 + ii; const float bv = bl[ii] + pre;
            const float qv = bf2f(qds[i * 136 + d]), kv = bf2f(kxs[i * 136 + d]);
            const float eb = __builtin_amdgcn_exp2f(bv * LOG2E); const float qd = qv * eb, kx = kv * __builtin_amdgcn_rcpf(eb);
            qds[i * 136 + d] = (bf16_t)(cvtpk(qd, qd) & 0xffffu); kxs[i * 136 + d] = (bf16_t)(cvtpk(kx, kx) & 0xffffu); }
        if (ig == 0) { const int dl = d & 31, r = (dl & 3) | ((dl >> 3) << 2), hh = (dl >> 2) & 1; gb.GD[(size_t)it * 128 + ((d >> 5) * 2 + hh) * 16 + r] = __builtin_amdgcn_exp2f(tot * LOG2E); }
        __syncthreads();
        bf16_t* QDi = gb.QD + (size_t)it * 8192; bf16_t* KXTi = gb.KXT + (size_t)it * 8192; bf16_t* ATTi = gb.ATT + (size_t)it * 4096;
#pragma unroll
        for (int u = 0; u < 2; ++u) { const int ch = F.tid + 512 * u;
            { const int i = ch >> 4, cb = ch & 15; *(u32x4*)(QDi + i * 128 + cb * 8) = *(const LAS u32x4*)(qds + i * 136 + cb * 8); }
            { const int d2 = ch & 127, jc = ch >> 7; unsigned short t[8];
#pragma unroll
              for (int jj = 0; jj < 8; ++jj) t[jj] = kxs[(jc * 8 + jj) * 136 + d2];
              u32x4 w = {(unsigned)t[0] | ((unsigned)t[1] << 16), (unsigned)t[2] | ((unsigned)t[3] << 16), (unsigned)t[4] | ((unsigned)t[5] << 16), (unsigned)t[6] | ((unsigned)t[7] << 16)};
              *(u32x4*)(KXTi + d2 * 64 + jc * 8) = w; } }
        if (F.wave < 4) { const int it_ = F.wave >> 1, jt = F.wave & 1;
            f32x16 acc = {};
            if (jt <= it_) {
#pragma unroll
                for (int ks = 0; ks < 8; ++ks) { const bf16x8 A = *(const LAS bf16x8*)(qds + (it_ * 32 + r32) * 136 + ks * 16 + 8 * hi); const bf16x8 B = *(const LAS bf16x8*)(kxs + (jt * 32 + r32) * 136 + ks * 16 + 8 * hi);
                    acc = __builtin_amdgcn_mfma_f32_32x32x16_bf16(A, B, acc, 0, 0, 0); } }
#pragma unroll
            for (int r = 0; r < 16; ++r) { const int i = it_ * 32 + crow(r, hi), j = jt * 32 + r32; const float v = (j <= i) ? acc[r] : 0.f; ATTi[i * 64 + j] = (bf16_t)(cvtpk(v, v) & 0xffffu); } }
    }
#undef PREP_FETCH
    __syncthreads();
}

__device__ __forceinline__ int v_st2(int k, int c) { const int kk = (k & ~0xC) | ((k & 4) << 1) | ((k & 8) >> 1); return ((kk >> 3) * 2 + (c >> 5)) * 512 + ((kk & 7) * 32 + (c & 31)) * 2; }
__device__ __forceinline__ int v_rd_base(int lane) { return ((lane & 3) << 3) | (((lane >> 2) & 3) << 6) | (((lane >> 4) & 1) << 5) | (((lane >> 5) & 1) << 8); }
constexpr int v_rd_off2(int ks, int half) { return ks * 2048 + half * 1024; }
template <int OFF> __device__ __forceinline__ s16x4 tr_read(int vb) { s16x4 r; asm volatile("ds_read_b64_tr_b16 %0, %1 offset:%2" : "=&v"(r) : "v"(vb), "i"(OFF) : "memory"); return r; }

constexpr int NGRP = 4, GCH = NCH / NGRP;
static_assert(NGRP * GCH == NCH && (GCH & 1) == 1, "scan groups");
constexpr int SC_SLOT = 49664, SC_QD = 0, SC_KX = 16384, SC_AT = 32768, SC_V = 40960, SC_GD = 49152, SC_SB = 2 * SC_SLOT, SC_OS = SC_SB + 2 * 8704 * 2;
static_assert(SC_OS + 2 * 8192 + 64 <= LDS_BYTES, "scan LDS map");

__device__ __forceinline__ void scan_pass1(const Frame& F, const GlaBufs& gb, int nrows) {
    const int nb = nrows / ROWS, nchains = nb * 32;
    if (F.bid >= (NGRP - 1) * nchains) return;
    const int dt = F.wave >> 1, et = F.wave & 1, r32 = F.lane & 31, hi = F.lane >> 5, t = F.tid;
    LAS unsigned char* L = F.lds;
    const int wk0 = ((t >> 3) * 128) + ((((t & 7) ^ ((t >> 4) & 7))) << 4), wk1 = (((t + 512) >> 3) * 128) + (((((t + 512) & 7) ^ (((t + 512) >> 4) & 7))) << 4);
    const int wv0 = v_st2(t >> 3, (t & 7) * 8);
    const int rkx = SC_KX + (dt * 32 + r32) * 128, skx = ((dt * 32 + r32) >> 1) & 7;
    const int vrd = v_rd_base(F.lane) + et * 512;
    const int ch = F.bid % nchains, g = F.bid / nchains; const int es = ch & 3, dir = (ch >> 2) & 1, h = (ch >> 3) & 3, b = ch >> 5;
    const int lb = b * ROWS; const int item0 = ((b * 4 + h) * 2 + dir) * NCH; const int c0 = g * GCH, c1 = c0 + GCH;
    const unsigned vcol = (unsigned)(lb * 1024 + h * 256 + es * 64 + (t & 7) * 8);
    f32x16 S = {}, Dg;
#pragma unroll
    for (int r = 0; r < 16; ++r) Dg[r] = 1.f;
    u32x4 pk0[2], pk1[2], pv0[2]; f32x4 pg0[2] = {{0.f, 0.f, 0.f, 0.f}, {0.f, 0.f, 0.f, 0.f}};
#define P1_LOAD(c, Z) do { const size_t item_ = (size_t)(item0 + (c)); const int base_ = chunk_base(dir, (c)); \
        const u32x4* k_ = (const u32x4*)(gb.KXT + item_ * 8192) + t; pk0[Z] = k_[0]; pk1[Z] = k_[512]; \
        { const int j_ = t >> 3; const int row_ = dir ? base_ + 63 - j_ : base_ + j_; pv0[Z] = *(const u32x4*)(gb.Vg + (vcol + (unsigned)row_ * 1024u)); } \
        pg0[Z] = ((const f32x4*)(gb.GD + item_ * 128))[t & 31]; } while (0)
#define P1_STEP(c, PAR) do { LAS unsigned char* s_ = L + (PAR) * SC_SLOT; \
        *(LAS u32x4*)(s_ + SC_KX + wk0) = pk0[PAR]; *(LAS u32x4*)(s_ + SC_KX + wk1) = pk1[PAR]; *(LAS u32x4*)(s_ + SC_V + wv0) = pv0[PAR]; if (t < 32) *(LAS f32x4*)(s_ + SC_GD + t * 16) = pg0[PAR]; \
        __syncthreads(); \
        if ((c) + 2 < c1) P1_LOAD((c) + 2, PAR); \
        bf16x8 vb_[4]; \
        { const int vr_ = (int)(uintptr_t)(s_ + SC_V) + vrd; \
          const s16x4 l0 = tr_read<v_rd_off2(0, 0)>(vr_), h0 = tr_read<v_rd_off2(0, 1)>(vr_), l1 = tr_read<v_rd_off2(1, 0)>(vr_), h1 = tr_read<v_rd_off2(1, 1)>(vr_); \
          const s16x4 l2 = tr_read<v_rd_off2(2, 0)>(vr_), h2 = tr_read<v_rd_off2(2, 1)>(vr_), l3 = tr_read<v_rd_off2(3, 0)>(vr_), h3 = tr_read<v_rd_off2(3, 1)>(vr_); \
          asm volatile("s_waitcnt lgkmcnt(0)" ::: "memory"); __builtin_amdgcn_sched_barrier(0); \
          vb_[0] = (bf16x8){l0[0], l0[1], l0[2], l0[3], h0[0], h0[1], h0[2], h0[3]}; vb_[1] = (bf16x8){l1[0], l1[1], l1[2], l1[3], h1[0], h1[1], h1[2], h1[3]}; \
          vb_[2] = (bf16x8){l2[0], l2[1], l2[2], l2[3], h2[0], h2[1], h2[2], h2[3]}; vb_[3] = (bf16x8){l3[0], l3[1], l3[2], l3[3], h3[0], h3[1], h3[2], h3[3]}; } \
        _Pragma("unroll") for (int ks = 0; ks < 4; ++ks) { const bf16x8 kf_ = *(const LAS bf16x8*)(s_ + rkx + (((2 * ks + hi) ^ skx) << 4)); S = __builtin_amdgcn_mfma_f32_32x32x16_bf16(kf_, vb_[ks], S, 0, 0, 0); } \
        { const LAS f32x4* gp_ = (const LAS f32x4*)(s_ + SC_GD + (dt * 2 + hi) * 64); \
          _Pragma("unroll") for (int q = 0; q < 4; ++q) { const f32x4 g_ = gp_[q]; S[4 * q] *= g_.x; S[4 * q + 1] *= g_.y; S[4 * q + 2] *= g_.z; S[4 * q + 3] *= g_.w; \
              Dg[4 * q] *= g_.x; Dg[4 * q + 1] *= g_.y; Dg[4 * q + 2] *= g_.z; Dg[4 * q + 3] *= g_.w; } } \
    } while (0)
    P1_LOAD(c0, 0); P1_LOAD(c0 + 1, 1);
    for (int i = 0; i + 1 < GCH; i += 2) { P1_STEP(c0 + i, 0); P1_STEP(c0 + i + 1, 1); }
    P1_STEP(c1 - 1, 0);
#undef P1_LOAD
#undef P1_STEP
    f32x4* Eo = (f32x4*)(gb.ES + ((size_t)F.bid * NTHR + t) * 16); f32x4* Do = (f32x4*)(gb.DS + ((size_t)F.bid * NTHR + t) * 16);
#pragma unroll
    for (int q = 0; q < 4; ++q) { Eo[q] = (f32x4){S[4 * q], S[4 * q + 1], S[4 * q + 2], S[4 * q + 3]}; Do[q] = (f32x4){Dg[4 * q], Dg[4 * q + 1], Dg[4 * q + 2], Dg[4 * q + 3]}; }
    __syncthreads();
}

__device__ __forceinline__ void scan_pass2(const Frame& F, const GlaBufs& gb, int nrows) {
    const int nb = nrows / ROWS, nchains = nb * 32;
    if (F.bid >= NGRP * nchains) return;
    const int dt = F.wave >> 1, et = F.wave & 1, r32 = F.lane & 31, hi = F.lane >> 5, t = F.tid;
    constexpr int SLOT = SC_SLOT, O_QD = SC_QD, O_KX = SC_KX, O_AT = SC_AT, O_V = SC_V, O_GD = SC_GD, O_SB = SC_SB, O_OS = SC_OS;
    LAS unsigned char* L = F.lds;
    const int wq0 = ((t >> 4) * 256) + ((((t & 15) ^ ((t >> 4) & 15))) << 4), wq1 = (((t + 512) >> 4) * 256) + (((((t + 512) & 15) ^ (((t + 512) >> 4) & 15))) << 4);
    const int wk0 = ((t >> 3) * 128) + ((((t & 7) ^ ((t >> 4) & 7))) << 4), wk1 = (((t + 512) >> 3) * 128) + (((((t + 512) & 7) ^ (((t + 512) >> 4) & 7))) << 4);
    const int wa0 = wk0, wv0 = v_st2(t >> 3, (t & 7) * 8);
    const int rkx = O_KX + (dt * 32 + r32) * 128, skx = ((dt * 32 + r32) >> 1) & 7;
    const int rqd = O_QD + ((dt & 1) * 32 + r32) * 256, sqd = r32 & 15;
    const int rat = O_AT + ((dt & 1) * 32 + r32) * 128, sat = (((dt & 1) * 32 + r32) >> 1) & 7;
    const int vrd = v_rd_base(F.lane) + et * 512;
    {
        const int ch = F.bid % nchains, g = F.bid / nchains; const int es = ch & 3, dir = (ch >> 2) & 1, h = (ch >> 3) & 3, b = ch >> 5;
        const int lb = b * ROWS; const int item0 = ((b * 4 + h) * 2 + dir) * NCH; const int c0 = g * GCH, c1 = c0 + GCH;
        bf16_t* const Obase = dir ? gb.OB : gb.OF;
        const unsigned ocol = (unsigned)(lb * 1024 + h * 256 + es * 64 + (t & 7) * 8);
        const unsigned vcol = (unsigned)(lb * 1024 + h * 256 + es * 64 + (t & 7) * 8);
        f32x16 S = {};
        u32x4 pq0[2], pq1[2], pk0[2], pk1[2], pa0[2], pv0[2]; f32x4 pg0[2] = {{0.f, 0.f, 0.f, 0.f}, {0.f, 0.f, 0.f, 0.f}};
#define GLA_LOAD(c, Z) do { const size_t item_ = (size_t)(item0 + (c)); const int base_ = chunk_base(dir, (c)); \
            const u32x4* q_ = (const u32x4*)(gb.QD + item_ * 8192) + t; pq0[Z] = q_[0]; pq1[Z] = q_[512]; \
            const u32x4* k_ = (const u32x4*)(gb.KXT + item_ * 8192) + t; pk0[Z] = k_[0]; pk1[Z] = k_[512]; \
            pa0[Z] = ((const u32x4*)(gb.ATT + item_ * 4096))[t]; \
            { const int j_ = t >> 3; const int row_ = dir ? base_ + 63 - j_ : base_ + j_; pv0[Z] = *(const u32x4*)(gb.Vg + (vcol + (unsigned)row_ * 1024u)); } \
            pg0[Z] = ((const f32x4*)(gb.GD + item_ * 128))[t & 31]; } while (0)
#define GLA_STAGE(PAR) do { LAS unsigned char* s_ = L + (PAR) * SLOT; \
            *(LAS u32x4*)(s_ + O_QD + wq0) = pq0[PAR]; *(LAS u32x4*)(s_ + O_QD + wq1) = pq1[PAR]; *(LAS u32x4*)(s_ + O_KX + wk0) = pk0[PAR]; *(LAS u32x4*)(s_ + O_KX + wk1) = pk1[PAR]; \
            *(LAS u32x4*)(s_ + O_AT + wa0) = pa0[PAR]; *(LAS u32x4*)(s_ + O_V + wv0) = pv0[PAR]; if (t < 32) *(LAS f32x4*)(s_ + O_GD + t * 16) = pg0[PAR]; } while (0)
#define GLA_STEP(c, PAR) do { \
            GLA_STAGE(PAR); \
            __syncthreads(); \
            if ((c) + 2 < c1) GLA_LOAD((c) + 2, PAR); \
            if ((c) > c0) { const int i_ = t >> 3; const int pb_ = chunk_base(dir, (c) - 1); const int rw_ = dir ? pb_ + 63 - i_ : pb_ + i_; \
                *(u32x4*)(Obase + (ocol + (unsigned)rw_ * 1024u)) = *(const LAS u32x4*)(L + O_OS + (1 - (PAR)) * 8192 + t * 16); } \
            const LAS unsigned char* s_ = L + (PAR) * SLOT; \
            bf16x8 vb_[4]; \
            { const int vr_ = (int)(uintptr_t)(s_ + O_V) + vrd; \
              const s16x4 l0 = tr_read<v_rd_off2(0, 0)>(vr_), h0 = tr_read<v_rd_off2(0, 1)>(vr_), l1 = tr_read<v_rd_off2(1, 0)>(vr_), h1 = tr_read<v_rd_off2(1, 1)>(vr_); \
              const s16x4 l2 = tr_read<v_rd_off2(2, 0)>(vr_), h2 = tr_read<v_rd_off2(2, 1)>(vr_), l3 = tr_read<v_rd_off2(3, 0)>(vr_), h3 = tr_read<v_rd_off2(3, 1)>(vr_); \
              asm volatile("s_waitcnt lgkmcnt(0)" ::: "memory"); __builtin_amdgcn_sched_barrier(0); \
              vb_[0] = (bf16x8){l0[0], l0[1], l0[2], l0[3], h0[0], h0[1], h0[2], h0[3]}; vb_[1] = (bf16x8){l1[0], l1[1], l1[2], l1[3], h1[0], h1[1], h1[2], h1[3]}; \
              vb_[2] = (bf16x8){l2[0], l2[1], l2[2], l2[3], h2[0], h2[1], h2[2], h2[3]}; vb_[3] = (bf16x8){l3[0], l3[1], l3[2], l3[3], h3[0], h3[1], h3[2], h3[3]}; } \
            _Pragma("unroll") for (int ks = 0; ks < 4; ++ks) { const bf16x8 kf_ = *(const LAS bf16x8*)(s_ + rkx + (((2 * ks + hi) ^ skx) << 4)); S = __builtin_amdgcn_mfma_f32_32x32x16_bf16(kf_, vb_[ks], S, 0, 0, 0); } \
            if (dt < 2) { f32x16 o_ = {}; const LAS bf16_t* sp_ = (const LAS bf16_t*)(L + O_SB) + (PAR) * 8704 + (et * 32 + r32) * 136 + 8 * hi; \
                _Pragma("unroll") for (int ks = 0; ks < 8; ++ks) { const bf16x8 qf_ = *(const LAS bf16x8*)(s_ + rqd + (((2 * ks + hi) ^ sqd) << 4)); const bf16x8 sf_ = *(const LAS bf16x8*)(sp_ + 16 * ks); \
                    o_ = __builtin_amdgcn_mfma_f32_32x32x16_bf16(qf_, sf_, o_, 0, 0, 0); } \
                _Pragma("unroll") for (int ks = 0; ks < 4; ++ks) { const bf16x8 af_ = *(const LAS bf16x8*)(s_ + rat + (((2 * ks + hi) ^ sat) << 4)); o_ = __builtin_amdgcn_mfma_f32_32x32x16_bf16(af_, vb_[ks], o_, 0, 0, 0); } \
                LAS bf16_t* os_ = (LAS bf16_t*)(L + O_OS + (PAR) * 8192) + et * 32 + r32; \
                _Pragma("unroll") for (int r = 0; r < 16; ++r) os_[(dt * 32 + crow(r, hi)) * 64] = (bf16_t)(cvtpk(o_[r], o_[r]) & 0xffffu); } \
            { const LAS f32x4* gp_ = (const LAS f32x4*)(s_ + O_GD + (dt * 2 + hi) * 64); \
              _Pragma("unroll") for (int q = 0; q < 4; ++q) { const f32x4 g_ = gp_[q]; S[4 * q] *= g_.x; S[4 * q + 1] *= g_.y; S[4 * q + 2] *= g_.z; S[4 * q + 3] *= g_.w; } } \
            { LAS bf16_t* sw_ = (LAS bf16_t*)(L + O_SB) + (1 - (PAR)) * 8704 + (et * 32 + r32) * 136 + dt * 32 + 4 * hi; \
              _Pragma("unroll") for (int gq = 0; gq < 4; ++gq) { u32x2 w_; w_.x = cvtpk(S[4 * gq], S[4 * gq + 1]); w_.y = cvtpk(S[4 * gq + 2], S[4 * gq + 3]); *(LAS u32x2*)(sw_ + 8 * gq) = w_; } } \
        } while (0)
        GLA_LOAD(c0, 0); GLA_LOAD(c0 + 1, 1);
        if (g > 0) {
            { const f32x4* Ei = (const f32x4*)(gb.ES + ((size_t)ch * NTHR + t) * 16);
#pragma unroll
              for (int q = 0; q < 4; ++q) { const f32x4 e_ = Ei[q]; S[4 * q] = e_.x; S[4 * q + 1] = e_.y; S[4 * q + 2] = e_.z; S[4 * q + 3] = e_.w; } }
            for (int j = 1; j < g; ++j) { const f32x4* Ei = (const f32x4*)(gb.ES + ((size_t)(j * nchains + ch) * NTHR + t) * 16); const f32x4* Di = (const f32x4*)(gb.DS + ((size_t)(j * nchains + ch) * NTHR + t) * 16);
#pragma unroll
              for (int q = 0; q < 4; ++q) { const f32x4 e_ = Ei[q], d_ = Di[q]; S[4 * q] = S[4 * q] * d_.x + e_.x; S[4 * q + 1] = S[4 * q + 1] * d_.y + e_.y; S[4 * q + 2] = S[4 * q + 2] * d_.z + e_.z; S[4 * q + 3] = S[4 * q + 3] * d_.w + e_.w; } }
        }
        { LAS bf16_t* sw_ = (LAS bf16_t*)(L + O_SB) + (et * 32 + r32) * 136 + dt * 32 + 4 * hi;
#pragma unroll
          for (int gq = 0; gq < 4; ++gq) { u32x2 w_; w_.x = cvtpk(S[4 * gq], S[4 * gq + 1]); w_.y = cvtpk(S[4 * gq + 2], S[4 * gq + 3]); *(LAS u32x2*)(sw_ + 8 * gq) = w_; } }
        for (int i = 0; i + 1 < GCH; i += 2) { GLA_STEP(c0 + i, 0); GLA_STEP(c0 + i + 1, 1); }
        GLA_STEP(c1 - 1, 0);
        __syncthreads();
        { const int i_ = t >> 3; const int pb_ = chunk_base(dir, c1 - 1); const int rw_ = dir ? pb_ + 63 - i_ : pb_ + i_;
          *(u32x4*)(Obase + (ocol + (unsigned)rw_ * 1024u)) = *(const LAS u32x4*)(L + O_OS + t * 16); }
        __syncthreads();
#undef GLA_LOAD
#undef GLA_STAGE
#undef GLA_STEP
    }
}

__device__ __forceinline__ void out_phase(const Frame& F, const Args& a, const GlaBufs& gb, bf16_t* OG, int nrows) {
    const int gw = F.bid * NWAVES + F.wave, NGW = F.G * NWAVES; const int nb = nrows / ROWS;
    const f32x4 ng0 = *(const f32x4*)(a.in[IN_GLANG] + 8 * (F.lane & 31)), ng1 = *(const f32x4*)(a.in[IN_GLANG] + 8 * (F.lane & 31) + 4);
    for (int i = gw; i < nb * SEQ; i += NGW) { const size_t lr = (size_t)(i / SEQ) * ROWS + CTX + (i % SEQ);
        const u32x4* pf = (const u32x4*)(gb.OF + lr * 1024) + F.lane; const u32x4* pb = (const u32x4*)(gb.OB + lr * 1024) + F.lane; const u32x4* pg = (const u32x4*)(gb.Gg + lr * 1024) + F.lane;
        u32x4* po = (u32x4*)(OG + lr * 1024) + F.lane;
        u32x4 af[2], ab[2], ag[2];
#pragma unroll
        for (int j = 0; j < 2; ++j) { af[j] = pf[64 * j]; ab[j] = pb[64 * j]; ag[j] = pg[64 * j]; }
#pragma unroll
        for (int j = 0; j < 2; ++j) { float o[8], g[8]; float ss = 0.f;
#pragma unroll
            for (int e = 0; e < 4; ++e) { o[2 * e] = __uint_as_float(af[j][e] << 16) + __uint_as_float(ab[j][e] << 16); o[2 * e + 1] = __uint_as_float(af[j][e] & 0xffff0000u) + __uint_as_float(ab[j][e] & 0xffff0000u);
                g[2 * e] = __uint_as_float(ag[j][e] << 16); g[2 * e + 1] = __uint_as_float(ag[j][e] & 0xffff0000u); ss += o[2 * e] * o[2 * e] + o[2 * e + 1] * o[2 * e + 1]; }
            ss = half_sum32(ss);
            const float rs = rsqrtf(ss * (1.f / 256.f) + EPS);
            const float n[8] = {ng0.x, ng0.y, ng0.z, ng0.w, ng1.x, ng1.y, ng1.z, ng1.w}; float y[8];
#pragma unroll
            for (int e = 0; e < 8; ++e) y[e] = o[e] * rs * n[e] * fsilu(g[e]);
            u32x4 w; w.x = cvtpk(y[0], y[1]); w.y = cvtpk(y[2], y[3]); w.z = cvtpk(y[4], y[5]); w.w = cvtpk(y[6], y[7]); po[64 * j] = w; }
    }
}
}

struct LatentOrder {
    pg8::StaticOrder so;
    __device__ void init(int nb, int N, int G, int c) { so.init(nb * 64 * 256, N, G, c); }
    __device__ bool next(int i, pg8::Unit& u) const { if (!so.next(i, u)) return false; u.pm = (u.pm >> 6) * 65 + 1 + (u.pm & 63); return true; }
};
#define XB_TMO      128
#define XB_XCNT(j)  (256  + 64 * (j))
#define XB_XSUB(j)  (1280 + 64 * (j))
#define XB_XGEN(j)  (2304 + 64 * (j))
#define XB_TOP      3328
#define XB_TOPGEN   3392
#define XCD_BAR_WORDS 3456
#define XB_SPIN_CAP (1u << 18)

__device__ __forceinline__ unsigned xb_ld(unsigned* p)              { return __hip_atomic_load(p, __ATOMIC_RELAXED, __HIP_MEMORY_SCOPE_AGENT); }
__device__ __forceinline__ unsigned xb_add(unsigned* p, unsigned v) { return __hip_atomic_fetch_add(p, v, __ATOMIC_RELAXED, __HIP_MEMORY_SCOPE_AGENT); }
__device__ __forceinline__ unsigned xb_xcc_id() { return (unsigned)__builtin_amdgcn_s_getreg((3 << 11) | 20) & 0xFu; }
#define XB_SPIN(cond, bar) do { unsigned _sp = 0; while (cond) { __builtin_amdgcn_s_sleep(1); \
    if ((++_sp & 255u) == 0u) { if (xb_ld(&(bar)[XB_TMO])) break; if (_sp > XB_SPIN_CAP) { atomicAdd(&(bar)[XB_TMO], 1u); break; } } } } while (0)

struct XcdBarrier {
    unsigned* bar; unsigned x;
    volatile LAS unsigned* st;
};

__device__ __forceinline__ XcdBarrier xcd_barrier_post(unsigned* bar, volatile LAS unsigned* st) {
    XcdBarrier b; b.bar = bar; b.x = xb_xcc_id(); b.st = st;
    if (threadIdx.x == 0) (void)xb_add(&bar[XB_XCNT(b.x)], 1u);
    return b;
}
__device__ __forceinline__ void xcd_barrier_complete(unsigned* bar, unsigned x, unsigned& nloc, unsigned& nx) {
    const unsigned G = gridDim.x * gridDim.y * gridDim.z;
    unsigned sum, cnt, mine, sp = 0u;
    for (;;) {
        sum = 0u; cnt = 0u; mine = 0u;
#pragma unroll
        for (unsigned j = 0; j < 16; ++j) { const unsigned c = xb_ld(&bar[XB_XCNT(j)]); sum += c; cnt += (c > 0u) ? 1u : 0u; mine = (j == x) ? c : mine; }
        if (sum == G) break;
        __builtin_amdgcn_s_sleep(1);
        if ((++sp & 255u) == 0u) { if (xb_ld(&bar[XB_TMO])) break; if (sp > XB_SPIN_CAP) { atomicAdd(&bar[XB_TMO], 1u); break; } }
    }
    nloc = mine > 0u ? mine : 1u; nx = cnt > 0u ? cnt : 1u;
}

__device__ __forceinline__ void xcd_barrier(const XcdBarrier& b) {
    asm volatile("s_waitcnt vmcnt(0)" ::: "memory");
    __syncthreads();
    if (threadIdx.x == 0) {
        unsigned* bar = b.bar;
        __builtin_amdgcn_s_waitcnt(0);
        unsigned nloc = b.st[0], nx = b.st[1];
        if (nloc == 0u) { xcd_barrier_complete(bar, b.x, nloc, nx); b.st[0] = nloc; b.st[1] = nx; }
        const unsigned old = xb_add(&bar[XB_XSUB(b.x)], 1u);
        const unsigned gen = old / nloc;
        if (old + 1u == (gen + 1u) * nloc) {
            __builtin_amdgcn_fence(__ATOMIC_RELEASE, "agent");
            asm volatile("s_waitcnt vmcnt(0)" ::: "memory");
            const unsigned og = xb_add(&bar[XB_TOP], 1u);
            const unsigned tg = og / nx;
            if (og + 1u == (tg + 1u) * nx) xb_add(&bar[XB_TOPGEN], 1u);
            else XB_SPIN(xb_ld(&bar[XB_TOPGEN]) == tg, bar);
            __builtin_amdgcn_fence(__ATOMIC_ACQUIRE, "agent");
            xb_add(&bar[XB_XGEN(b.x)], 1u);
            asm volatile("s_waitcnt vmcnt(0)" ::: "memory");
        } else {
            XB_SPIN(xb_ld(&bar[XB_XGEN(b.x)]) == gen, bar);
            __builtin_amdgcn_fence(__ATOMIC_ACQUIRE, "agent");
            asm volatile("s_waitcnt vmcnt(0)" ::: "memory");
        }
    }
    __syncthreads();
}


#ifndef MK_REPEAT
#define MK_REPEAT -1
#endif
#define REPS(k) ((MK_REPEAT) == (k) ? 2 : 1)
#ifndef MK_PER_PHASE
#define MK_PER_PHASE 0
#endif
struct Bufs {
    bf16_t *N, *HH, *Q, *K, *V, *MIX; bf16_t *Hl, *Hc, *H3; float* OUT; MoeBufs mb0, mb1; bf16_t *W13t, *W2t; GlaBufs gb; bf16_t *OG, *N2b;
};
__global__ void __launch_bounds__(NTHR, 2) mk_fwd(Args a, Bufs d) {
    extern __shared__ __attribute__((aligned(16))) unsigned char lds_raw[];
    Frame F; F.lds = (LAS unsigned char*)lds_raw; F.tid = threadIdx.x; F.lane = F.tid & 63; F.wave = __builtin_amdgcn_readfirstlane(F.tid >> 6); F.G = gridDim.x; F.bid = blockIdx.x;
#define IN(k) (a.ph_lo <= (k) && (k) < a.ph_hi)
#if MK_PER_PHASE
#define SEAM(k) do { } while (0)
#else
    cg::grid_group grid = cg::this_grid();
    volatile LAS unsigned* xst = (volatile LAS unsigned*)(F.lds + LDS_BYTES - 64);
    if (F.tid < 2) xst[F.tid] = 0u;
    __syncthreads();
    XcdBarrier xbar = xcd_barrier_post((unsigned*)(a.ws + FW_CTL + 4096), xst);
#define SEAM(k) do { if (IN(k) && IN((k) + 1)) { if ((k) == P_PRO_A) grid.sync(); else xcd_barrier(xbar); } } while (0)
#endif
    const HRows H{d.Hl, d.Hc};
    const HRows H3{d.H3, d.Hc};
    constexpr int WMOE_A = WMOE_ITEMS / 12, WMOE_B = WMOE_A + (WMOE_ITEMS * 39) / 100;
    if (IN(P_PRO_A)) for (int rep_ = 0; rep_ < REPS(P_PRO_A); ++rep_) { if (rep_) xcd_barrier(xbar); { for (int q_ = 0; q_ < ((MK_REPEAT) == 100 ? 2 : 1); ++q_) { phase_pro_a(F, a); __syncthreads(); } for (int q_ = 0; q_ < ((MK_REPEAT) == 101 ? 2 : 1); ++q_) { phase_wmoe(F, a, 0, d.W13t, d.W2t, 0, 0, 0, WMOE_A); __syncthreads(); } } }
    SEAM(P_PRO_A);
    if (IN(P_PRO_B)) for (int rep_ = 0; rep_ < REPS(P_PRO_B); ++rep_) { if (rep_) xcd_barrier(xbar); phase_pro_b(F, a, d.N); }
    SEAM(P_PRO_B);
    if (IN(P_INL0)) for (int rep_ = 0; rep_ < REPS(P_INL0); ++rep_) { if (rep_) xcd_barrier(xbar); {
        pg8::Gemm g{d.N, (const bf16_t*)(a.ws + FW_WIN0), 1024, 0, nullptr, nullptr, 0};
        pg8::StaticOrder S; S.init(RTOT, 2560, F.G, F.bid);
        EpiInL0 E{d.HH, d.Q, d.K, d.V, a.in[IN_QNG], a.in[IN_KNG], (const float2*)(a.ws + FW_ROPE), 0};
        pg8::gemm_phase<false>(F.lds, g, S, E);
        { const int nun = (RTOT / 256) * 10, extra = nun - (nun / F.G) * F.G; __syncthreads(); if (F.bid >= extra) phase_wmoe(F, a, 0, d.W13t, d.W2t, extra, F.G - extra, WMOE_A, WMOE_B); }
    } }
    SEAM(P_INL0);
    if (IN(P_ATT)) for (int rep_ = 0; rep_ < REPS(P_ATT); ++rep_) { if (rep_) xcd_barrier(xbar); { conv_phase(F, a, d.HH, d.MIX, 0, RTOT); attn_phase(F, a, (const unsigned char*)d.Q, (const unsigned char*)d.K, (const unsigned char*)d.V, d.MIX, RTOT); } }
    SEAM(P_ATT);
    if (IN(P_OUTL0)) for (int rep_ = 0; rep_ < REPS(P_OUTL0); ++rep_) { if (rep_) xcd_barrier(xbar); {
        pg8::Gemm g{d.MIX, (const bf16_t*)(a.ws + FW_WOUT0), 1024, 0, nullptr, nullptr, 0};
        pg8::StaticOrder S; S.init(RTOT, 1024, F.G, F.bid);
        EpiResid2<float> E{a.in[IN_X], a.in[IN_CTX], d.Hl, d.Hc, (const float*)(a.ws + FW_MODS), 2, 0};
        pg8::gemm_phase<false>(F.lds, g, S, E);
        { const int nun = (RTOT / 256) * 4, extra = nun - (nun / F.G) * F.G; __syncthreads(); if (F.bid >= extra) phase_wmoe(F, a, 0, d.W13t, d.W2t, extra, F.G - extra, WMOE_B, WMOE_ITEMS); }
    } }
    SEAM(P_OUTL0);
    if (IN(P_ROUTE0)) { int* cntW = (int*)(a.ws + FW_CTL + 65536); phase_route(F, a, 0, H, d.N, d.mb0, 0, RTOT, false, cntW); xcd_barrier(xbar); phase_route_scatter(F, d.mb0, cntW); }
    SEAM(P_ROUTE0);
    if (IN(P_UP0)) for (int rep_ = 0; rep_ < REPS(P_UP0); ++rep_) { if (rep_) xcd_barrier(xbar); phase_moe_up(F, d.N, d.W13t, d.mb0); }
    SEAM(P_UP0);
    if (IN(P_DOWN0)) for (int rep_ = 0; rep_ < REPS(P_DOWN0); ++rep_) { if (rep_) xcd_barrier(xbar); phase_moe_down(F, d.W2t, d.mb0); }
    SEAM(P_DOWN0);
    if (IN(P_COMB0)) phase_combine<false>(F, a, 0, H, d.mb0.YS, d.N, nullptr, 0, RTOT, false);
    SEAM(P_COMB0);
    if (IN(P_INL1)) for (int rep_ = 0; rep_ < REPS(P_INL1); ++rep_) { if (rep_) xcd_barrier(xbar); {
        pg8::Gemm g{d.N, (const bf16_t*)(a.ws + FW_WIN1), 1024, 0, nullptr, nullptr, 0};
        pg8::StaticOrder S; S.init(RTOT, 3328, F.G, F.bid);
        EpiInL1 E{d.gb};
        pg8::gemm_phase<false>(F.lds, g, S, E);
    } }
    SEAM(P_INL1);
    if (IN(P_GPREP)) for (int rep_ = 0; rep_ < REPS(P_GPREP); ++rep_) { if (rep_) xcd_barrier(xbar); gla::prep_phase(F, a, d.gb, RTOT); }
    SEAM(P_GPREP);
    if (IN(P_GSCAN)) {
        constexpr int WSPLIT = WMOE_ITEMS / 8;
        if (F.bid >= 192) phase_wmoe(F, a, 1, d.W13t, d.W2t, 192, F.G - 192, 0, WSPLIT); else gla::scan_pass1(F, d.gb, RTOT);
        xcd_barrier(xbar);
        gla::scan_pass2(F, d.gb, RTOT);
        phase_wmoe(F, a, 1, d.W13t, d.W2t, 0, 0, WSPLIT, WMOE_ITEMS);
    }
    SEAM(P_GSCAN);
    if (IN(P_GOUT)) for (int rep_ = 0; rep_ < REPS(P_GOUT); ++rep_) { if (rep_) xcd_barrier(xbar); gla::out_phase(F, a, d.gb, d.OG, RTOT); }
    SEAM(P_GOUT);
    if (IN(P_OUTL1)) {
        pg8::Gemm g{d.OG, (const bf16_t*)(a.ws + FW_WOUT1), 1024, 0, nullptr, nullptr, 0};
        LatentOrder S; S.init(2, 1024, F.G, F.bid);
        EpiResid2<bf16_t> E{d.Hl, d.Hc, d.H3, d.Hc, (const float*)(a.ws + FW_MODS) + 3 * 6144, 2, 0};
        pg8::gemm_phase<false>(F.lds, g, S, E);
    }
    SEAM(P_OUTL1);
    if (IN(P_ROUTE1)) { int* cntW = (int*)(a.ws + FW_CTL + 65536); phase_route(F, a, 1, H3, d.N2b, d.mb1, 0, RTOT, true, cntW); xcd_barrier(xbar); phase_route_scatter(F, d.mb1, cntW); }
    SEAM(P_ROUTE1);
    if (IN(P_UP1)) for (int rep_ = 0; rep_ < REPS(P_UP1); ++rep_) { if (rep_) xcd_barrier(xbar); phase_moe_up(F, d.N2b, d.W13t, d.mb1); }
    SEAM(P_UP1);
    if (IN(P_DOWN1)) for (int rep_ = 0; rep_ < REPS(P_DOWN1); ++rep_) { if (rep_) xcd_barrier(xbar); phase_moe_down(F, d.W2t, d.mb1); }
    SEAM(P_DOWN1);
    if (IN(P_COMB1)) phase_combine<true>(F, a, 1, H3, d.mb1.YS, nullptr, d.OUT, 0, RTOT, true);
#undef IN
#undef SEAM
}
__global__ void k_nan(float* out, size_t n) { size_t i = (size_t)blockIdx.x * 256 + threadIdx.x; if (i < n) out[i] = __builtin_nanf(""); }
}

extern "C" void kernel_launch(void* const* d_in, const int* in_sizes, int n_in, void* d_out, int out_size, void* d_ws, size_t ws_size, hipStream_t stream) {
  float* out = (float*)d_out; unsigned char* ws = (unsigned char*)d_ws;
  static int grid = 0;
  if (grid == 0) {
    int dev = 0, cus = 0, per_cu = 0; (void)hipGetDevice(&dev); (void)hipDeviceGetAttribute(&cus, hipDeviceAttributeMultiprocessorCount, dev);
    (void)hipFuncSetAttribute((const void*)mk_fwd, hipFuncAttributeMaxDynamicSharedMemorySize, LDS_BYTES);
    (void)hipOccupancyMaxActiveBlocksPerMultiprocessor(&per_cu, (const void*)mk_fwd, NTHR, LDS_BYTES);
    if (per_cu < 1) { fprintf(stderr, "kernel_launch: occupancy query says %d blocks per CU\n", per_cu); per_cu = 1; }
    grid = (cus > 0 ? cus : 256);
    (void)hipGetLastError();
  }
  if (FW_END > ws_size || n_in != 33 || out_size != 2 * SEQ * D) { fprintf(stderr, "kernel_launch: ws too small (%zu needed, %zu given) or n_in %d\n", (size_t)FW_END, ws_size, n_in);
    hipLaunchKernelGGL(k_nan, dim3((out_size + 255) / 256), dim3(256), 0, stream, out, (size_t)out_size); return; }
  (void)hipMemsetAsync(ws + FW_CTL, 0, 131072, stream);
  Args a{}; for (int i = 0; i < 33; ++i) a.in[i] = (const float*)d_in[i];
  a.out = out; a.ws = ws; a.row0 = 0; a.nrows = RTOT;
  Bufs b{};
  constexpr size_t R1 = (size_t)RTOT * 1024 * 2, Rh = (size_t)RTOT * 512 * 2;
  b.N = (bf16_t*)(ws + FW_RA); b.HH = (bf16_t*)(ws + FW_RB); b.Q = (bf16_t*)(ws + FW_RB + Rh); b.K = (bf16_t*)(ws + FW_RB + 2 * Rh); b.V = (bf16_t*)(ws + FW_RB + 3 * Rh);
  b.MIX = (bf16_t*)(ws + FW_RC); b.Hl = (bf16_t*)out; b.Hc = (bf16_t*)(ws + FW_HC); b.H3 = (bf16_t*)(ws + FW_RF); b.OUT = out;
  b.mb0.cnt = (int*)(ws + FW_CTL); b.mb0.tok = (int*)(ws + FW_RD); b.mb0.slot = (int*)(ws + FW_RD) + 32 * RTOT; b.mb0.gate = (float*)(ws + FW_RD) + 64 * RTOT;
  b.mb0.HB = (bf16_t*)(ws + FW_RB); b.mb0.YS = (bf16_t*)(ws + FW_RC); b.mb0.cap = RTOT; b.mb0.pad = 0;
  b.mb1 = b.mb0; b.mb1.cnt = (int*)(ws + FW_CTL) + 64;
  b.W13t = (bf16_t*)(ws + FW_W13); b.W2t = (bf16_t*)(ws + FW_W2);
  b.gb.Qg = (bf16_t*)(ws + FW_RB); b.gb.Kg = (bf16_t*)(ws + FW_RB + Rh); b.gb.Vg = (bf16_t*)(ws + FW_RB + 2 * Rh);
  b.gb.Gg = (bf16_t*)(ws + FW_RC); b.gb.A1 = (float*)(ws + FW_RC + R1);
  b.gb.QD = (bf16_t*)(ws + FW_RA); b.gb.KXT = (bf16_t*)(ws + FW_RE); b.gb.ATT = (bf16_t*)(ws + FW_RC + 70 * MiB); b.gb.GD = (float*)(ws + FW_RC + 104 * MiB);
  b.gb.OF = (bf16_t*)(ws + FW_RB); b.gb.OB = (bf16_t*)(ws + FW_RF);
  b.gb.ES = (float*)(ws + FW_RC + 108 * MiB); b.gb.DS = (float*)(ws + FW_RC + 116 * MiB);
  b.OG = (bf16_t*)(ws + FW_RA); b.N2b = (bf16_t*)(ws + FW_RE);
#if MK_PER_PHASE
  for (int ph = 0; ph < P_COUNT; ++ph) { a.ph_lo = ph; a.ph_hi = ph + 1; hipLaunchKernelGGL(mk_fwd, dim3(grid), dim3(NTHR), LDS_BYTES, stream, a, b); }
#else
  a.ph_lo = 0; a.ph_hi = P_COUNT;
  void* args[] = {&a, &b};
  hipError_t e = hipLaunchCooperativeKernel((const void*)mk_fwd, dim3(grid), dim3(NTHR), args, LDS_BYTES, stream);
  if (e != hipSuccess) fprintf(stderr, "kernel_launch: cooperative launch failed: %s (grid %d)\n", hipGetErrorString(e), grid);
#endif
}
```

```cpp
#define MK_PER_PHASE 0
#include <hip/hip_runtime.h>
#include <hip/hip_cooperative_groups.h>
#include <cstdio>
#include <cstdint>

namespace {
namespace cg = cooperative_groups;
constexpr int D = 1024, SEQ = 16384, CTX = 256, ROWS = SEQ + CTX;
constexpr float EPS = 1e-6f;

template <int CTRL> __device__ __forceinline__ float dpp_mov(float v) { return __int_as_float(__builtin_amdgcn_update_dpp(0, __float_as_int(v), CTRL, 0xf, 0xf, false)); }
__device__ __forceinline__ float row_sum16(float v) { v += dpp_mov<0xB1>(v); v += dpp_mov<0x4E>(v); v += dpp_mov<0x124>(v); v += dpp_mov<0x128>(v); return v; }
__device__ __forceinline__ float xor16_sum(float v) { auto r = __builtin_amdgcn_permlane16_swap(__float_as_uint(v), __float_as_uint(v), false, false); return __uint_as_float(r[0]) + __uint_as_float(r[1]); }
__device__ __forceinline__ float xor32_sum(float v) { auto r = __builtin_amdgcn_permlane32_swap(__float_as_uint(v), __float_as_uint(v), false, false); return __uint_as_float(r[0]) + __uint_as_float(r[1]); }
__device__ __forceinline__ float half_sum32(float v) { return xor16_sum(row_sum16(v)); }
__device__ __forceinline__ float wave_sum(float v) { return xor32_sum(xor16_sum(row_sum16(v))); }
#define LAS __attribute__((address_space(3)))
typedef unsigned short bf16_t;
typedef short bf16x8 __attribute__((ext_vector_type(8)));
typedef int v4i_t __attribute__((ext_vector_type(4)));
typedef int v8i_t __attribute__((ext_vector_type(8)));
typedef float f32x4 __attribute__((ext_vector_type(4)));
typedef float f32x16 __attribute__((ext_vector_type(16)));
typedef unsigned u32x4 __attribute__((ext_vector_type(4)));
typedef unsigned u32x2 __attribute__((ext_vector_type(2)));
typedef float f32x2_t __attribute__((ext_vector_type(2)));
typedef __bf16 bf16x2_t __attribute__((ext_vector_type(2)));

constexpr int RTOT = 2 * ROWS;
constexpr int NWAVES = 8, NTHR = 512;
constexpr int LDS_BYTES = 155648;
constexpr float LOG2E = 1.4426950408889634f;
constexpr float QSCALE = 0.125f * LOG2E;

__device__ __forceinline__ unsigned cvtpk(float lo, float hi) { f32x2_t v = {lo, hi}; bf16x2_t b = __builtin_convertvector(v, bf16x2_t); return __builtin_bit_cast(unsigned, b); }
__device__ __forceinline__ float bf2f(bf16_t h) { return __uint_as_float((unsigned)h << 16); }
__device__ __forceinline__ float fsigmoid(float x) { return __builtin_amdgcn_rcpf(1.f + __builtin_amdgcn_exp2f(-x * LOG2E)); }
__device__ __forceinline__ float fsilu(float x) { return x * fsigmoid(x); }

namespace pg8 {
constexpr int BM = 256, BK = 64, HALF = 128, HTB = HALF * BK * 2, STAGE_BYTES = 8 * HTB, NXCD = 8, WGM = 8;
__host__ __device__ __forceinline__ int lds_byte(int r, int c) { const int st = (r >> 4) * 2 + (c >> 5), rr = r & 15, cc = c & 31, ob = rr * 64 + cc * 2; return st * 1024 + (ob ^ (((ob >> 9) & 1) << 5)); }
__host__ __device__ __forceinline__ void stage_rc(int b, int& R, int& C) { const int st = b / 1024, sb = b % 1024, swz = sb ^ (((sb >> 9) & 1) << 5); R = (st >> 1) * 16 + swz / 64; C = (st & 1) * 32 + (swz % 64) / 2; }
__host__ __device__ __forceinline__ int perm32(int rho) { const int n = rho >> 4, i = rho & 15; return 8 * (i >> 2) + 4 * n + (i & 3); }

struct Unit { int pm, pn, e, j; };
struct Gemm { const bf16_t* A; const bf16_t* Bt; int K; long bstride; const int* aidx; const int* cnt; int cap; };

struct StaticOrder {
    int nM, nN, nwg, G, c;
    __device__ void init(int M, int N, int G_, int c_) { nM = M / BM; nN = N / BM; nwg = nM * nN; G = G_; c = c_; }
    __device__ bool next(int i, Unit& u) const {
        const long L = (long)i * G + c; if (L >= nwg) return false;
        int wgid = (int)L; { const int q = nwg / NXCD, r = nwg % NXCD, xcd = wgid % NXCD, off = wgid / NXCD; wgid = (xcd < r ? xcd * (q + 1) : r * (q + 1) + (xcd - r) * q) + off; }
        const int nig = WGM * nN, gid = wgid / nig, fm = gid * WGM, gsz = (nM - fm) < WGM ? (nM - fm) : WGM;
        u.pm = fm + ((wgid % nig) % gsz); u.pn = (wgid % nig) / gsz; u.e = 0; u.j = 0; return true;
    }
};

template <bool GATHER, class Epi, class Sched>
__device__ __forceinline__ void gemm_phase(LAS unsigned char* lds, const Gemm g, const Sched& S, const Epi& E) {
    const int tid = threadIdx.x, wid = __builtin_amdgcn_readfirstlane(tid >> 6), lane = tid & 63, wr = wid >> 2, wc = wid & 3, fr = lane & 15, fq = lane >> 4;
    const int K = g.K, nt = K / BK;
    int Rst[2], Cst[2]; unsigned voffB[2];
#pragma unroll
    for (int i = 0; i < 2; ++i) { int R, C; stage_rc(tid * 16 + i * 8192, R, C); Rst[i] = R; Cst[i] = C; const int Rb = Epi::PERM ? ((R & ~31) + perm32(R & 31)) : R; voffB[i] = (unsigned)(Rb * K + C) * 2u; }
    const size_t kstep = (size_t)(BK * 2);
    const size_t hstep = (size_t)HALF * K * 2;
    constexpr bool HN = Epi::FP8;
    const size_t tstep = HN ? hstep : 2 * hstep;
    const unsigned ldsw = (unsigned)wid * 1024u;
    const int aoff = lds_byte(wr * 64 + fr, fq * 8), boff = lds_byte(wc * 32 + fr, fq * 8);
#define PG8_SA(b, h) (((b) * 2 + (h)) * HTB)
#define PG8_SB(b, h) ((4 + (b) * 2 + (h)) * HTB)
#define PG8_STAGE(bufoff, gbase, voff) do { _Pragma("unroll") for (int _i = 0; _i < 2; ++_i) \
        __builtin_amdgcn_global_load_lds((const unsigned*)((const char*)(gbase) + (voff)[_i]), (LAS unsigned*)(lds + (bufoff) + ldsw + _i * 8192), 16, 0, 0); } while (0)
#define PG8_LD8(p_) __builtin_shufflevector(*(const LAS v4i_t*)(p_), *(const LAS v4i_t*)((p_) + 1024), 0, 1, 2, 3, 4, 5, 6, 7)
#define PG8_LDA(dst, b, h) do { if constexpr (HN) { _Pragma("unroll") for (int m = 0; m < 4; ++m) dst##8[m] = PG8_LD8(lds + PG8_SA(b, h) + aoff + m * 2048); } \
        else { _Pragma("unroll") for (int m = 0; m < 4; ++m) _Pragma("unroll") for (int k = 0; k < 2; ++k) dst[m][k] = *(const LAS bf16x8*)(lds + PG8_SA(b, h) + aoff + m * 2048 + k * 1024); } } while (0)
#define PG8_LDB(dst, b, h) do { if constexpr (HN) { _Pragma("unroll") for (int n = 0; n < 2; ++n) dst##8[n] = PG8_LD8(lds + PG8_SB(b, h) + boff + n * 2048); } \
        else { _Pragma("unroll") for (int n = 0; n < 2; ++n) _Pragma("unroll") for (int k = 0; k < 2; ++k) dst[n][k] = *(const LAS bf16x8*)(lds + PG8_SB(b, h) + boff + n * 2048 + k * 1024); } } while (0)
#define PG8_MMA(ai, bj, At, Bt) do { __builtin_amdgcn_s_setprio(1); _Pragma("unroll") for (int m = 0; m < 4; ++m) _Pragma("unroll") for (int n = 0; n < 2; ++n) { \
        if constexpr (HN) acc[ai][bj][m][n] = __builtin_amdgcn_mfma_scale_f32_16x16x128_f8f6f4(Bt##8[n], At##8[m], acc[ai][bj][m][n], 0, 0, 0, 0, 0, 0); \
        else { _Pragma("unroll") for (int k = 0; k < 2; ++k) acc[ai][bj][m][n] = __builtin_amdgcn_mfma_f32_16x16x32_bf16(Bt[n][k], At[m][k], acc[ai][bj][m][n], 0, 0, 0); } } \
        __builtin_amdgcn_s_setprio(0); } while (0)
#define PG8_WAIT_V(n) asm volatile("s_waitcnt vmcnt(" #n ")" ::: "memory")
#define PG8_WAIT_L(n) asm volatile("s_waitcnt lgkmcnt(" #n ")" ::: "memory")
#define PG8_BAR __builtin_amdgcn_s_barrier()
#define PG8_SCHED __builtin_amdgcn_sched_barrier(0)
#define PG8_AOFFS(dst, u) do { int _v[2][2]; int _n = 0; const int _e = __builtin_amdgcn_readfirstlane((u).e); \
        if (GATHER) { _n = g.cnt[_e]; _Pragma("unroll") for (int _h = 0; _h < 2; ++_h) _Pragma("unroll") for (int _i = 0; _i < 2; ++_i) { \
            const int _p = 256 * (u).j + 128 * _h + Rst[_i]; _v[_h][_i] = g.aidx[(size_t)_e * g.cap + (_p < g.cap ? _p : g.cap - 1)]; } } \
        _Pragma("unroll") for (int _h = 0; _h < 2; ++_h) _Pragma("unroll") for (int _i = 0; _i < 2; ++_i) { const int _R = 128 * _h + Rst[_i]; long _row; \
            if (GATHER) { const int _p = 256 * (u).j + _R; _row = (_p < _n) ? _v[_h][_i] : 0; } else _row = 256L * (u).pm + _R; \
            dst[_h][_i] = (unsigned)((_row * K + Cst[_i]) * 2); } } while (0)
    Unit cur, nxt; int ui = 0;
    if (!S.next(0, cur)) return;
    f32x4 acc[2][2][4][2];
#pragma unroll
    for (int a = 0; a < 2; ++a)
#pragma unroll
        for (int b = 0; b < 2; ++b)
#pragma unroll
            for (int m = 0; m < 4; ++m)
#pragma unroll
                for (int n = 0; n < 2; ++n) acc[a][b][m][n] = (f32x4){0.f, 0.f, 0.f, 0.f};
    bf16x8 At[4][2], B0[2][2], B1[2][2];
    v8i_t At8[4], B08[2], B18[2];
    unsigned oa[2][2], na[2][2];
    PG8_AOFFS(oa, cur);
    const char* const Ab = (const char*)g.A;
    const char* cB = (const char*)g.Bt + ((size_t)cur.e * g.bstride) * 2 + (size_t)cur.pn * tstep;
    PG8_STAGE(PG8_SB(0, 0), cB, voffB); if constexpr (!HN) PG8_STAGE(PG8_SB(0, 1), cB + hstep, voffB); PG8_STAGE(PG8_SA(0, 0), Ab, oa[0]); PG8_STAGE(PG8_SA(0, 1), Ab, oa[1]);
    if (wr == 1) PG8_BAR;
    PG8_WAIT_V(2); PG8_BAR;
    PG8_STAGE(PG8_SB(1, 0), cB + kstep, voffB); PG8_STAGE(PG8_SA(1, 0), Ab + kstep, oa[0]); if constexpr (!HN) PG8_STAGE(PG8_SB(1, 1), cB + hstep + kstep, voffB);
    if constexpr (HN) PG8_WAIT_V(4); else PG8_WAIT_V(6);
    PG8_BAR;
    bool has_next = false; const char* nB = cB;
    if constexpr (GATHER) {
        has_next = S.next(1, nxt);
        if (has_next) { PG8_AOFFS(na, nxt); } else {
#pragma unroll
            for (int _h = 0; _h < 2; ++_h)
#pragma unroll
                for (int _i = 0; _i < 2; ++_i) na[_h][_i] = oa[_h][_i]; }
        nB = has_next ? (const char*)g.Bt + ((size_t)nxt.e * g.bstride) * 2 + (size_t)nxt.pn * tstep : cB;
    }
    for (;;) {
        if constexpr (!GATHER) {
            has_next = S.next(ui + 1, nxt);
            if (has_next) { PG8_AOFFS(na, nxt); } else {
#pragma unroll
                for (int _h = 0; _h < 2; ++_h)
#pragma unroll
                    for (int _i = 0; _i < 2; ++_i) na[_h][_i] = oa[_h][_i]; }
            nB = has_next ? (const char*)g.Bt + ((size_t)nxt.e * g.bstride) * 2 + (size_t)nxt.pn * tstep : cB;
        }
#ifdef MK_KX
        constexpr int KX_ = HN ? MK_KX : 1;
#else
        constexpr int KX_ = 1;
#endif
        for (int tt = 0; tt < nt * KX_; tt += 2) {
            const int t = KX_ > 1 ? (tt & (nt - 1)) : tt;
            const bool last = (tt == nt * KX_ - 2);
            const char* a1 = Ab + (size_t)(t + 1) * kstep;
            const int t2 = KX_ > 1 ? ((tt + 2) & (nt - 1)) : (t + 2);
            const char* a2 = last ? Ab : Ab + (size_t)t2 * kstep; const char* b2 = last ? nB : cB + (size_t)t2 * kstep;
            const char* a3 = a2 + kstep; const char* b3 = b2 + kstep;
            unsigned x2[2][2];
#pragma unroll
            for (int _h = 0; _h < 2; ++_h)
#pragma unroll
                for (int _i = 0; _i < 2; ++_i) x2[_h][_i] = last ? na[_h][_i] : oa[_h][_i];
            PG8_LDB(B0, 0, 0); if constexpr (!HN) PG8_LDB(B1, 0, 1); PG8_SCHED; PG8_LDA(At, 0, 0); PG8_STAGE(PG8_SA(1, 1), a1, oa[1]);
            if constexpr (HN) PG8_WAIT_V(6); else PG8_WAIT_V(8);
            PG8_WAIT_L(0); PG8_BAR; PG8_MMA(0, 0, At, B0); if constexpr (!HN) PG8_MMA(0, 1, At, B1); PG8_BAR; PG8_SCHED;
            PG8_LDA(At, 0, 1); PG8_STAGE(PG8_SB(0, 0), b2, voffB); if constexpr (!HN) PG8_STAGE(PG8_SB(0, 1), b2 + hstep, voffB); PG8_STAGE(PG8_SA(0, 0), a2, x2[0]);
            if constexpr (HN) PG8_WAIT_V(6); else PG8_WAIT_V(8);
            PG8_WAIT_L(0); PG8_BAR; PG8_MMA(1, 0, At, B0); if constexpr (!HN) PG8_MMA(1, 1, At, B1); PG8_BAR; PG8_SCHED;
            PG8_LDB(B0, 1, 0); if constexpr (!HN) PG8_LDB(B1, 1, 1); PG8_SCHED; PG8_LDA(At, 1, 0); PG8_STAGE(PG8_SA(0, 1), a2, x2[1]);
            if constexpr (HN) PG8_WAIT_V(6); else PG8_WAIT_V(8);
            PG8_WAIT_L(0); PG8_BAR; PG8_MMA(0, 0, At, B0); if constexpr (!HN) PG8_MMA(0, 1, At, B1); PG8_BAR; PG8_SCHED;
            PG8_LDA(At, 1, 1); PG8_STAGE(PG8_SB(1, 0), b3, voffB); if constexpr (!HN) PG8_STAGE(PG8_SB(1, 1), b3 + hstep, voffB); PG8_STAGE(PG8_SA(1, 0), a3, x2[0]);
            if constexpr (HN) PG8_WAIT_V(6); else PG8_WAIT_V(8);
            PG8_WAIT_L(0); PG8_BAR; PG8_MMA(1, 0, At, B0); if constexpr (!HN) PG8_MMA(1, 1, At, B1); PG8_BAR; PG8_SCHED;
        }
        if (wr == 0) PG8_BAR;
        Unit nn; bool has_nn = false; unsigned nna[2][2]; const char* nnB = nB;
        if constexpr (GATHER) {
            has_nn = has_next && S.next(ui + 2, nn);
            if (has_nn) { PG8_AOFFS(nna, nn); nnB = (const char*)g.Bt + ((size_t)nn.e * g.bstride) * 2 + (size_t)nn.pn * tstep; } else {
#pragma unroll
                for (int _h = 0; _h < 2; ++_h)
#pragma unroll
                    for (int _i = 0; _i < 2; ++_i) nna[_h][_i] = na[_h][_i]; }
        }
        E(acc, cur, wr, wc, fr, fq);
#ifdef MK_EPIX
        if constexpr (HN) {
#pragma unroll 1
            for (int r_ = 1; r_ < MK_EPIX; ++r_) { asm volatile("" ::: "memory"); E(acc, cur, wr, wc, fr, fq); } }
#endif
        if (!has_next) break;
#pragma unroll
        for (int a = 0; a < 2; ++a)
#pragma unroll
            for (int b = 0; b < 2; ++b)
#pragma unroll
                for (int m = 0; m < 4; ++m)
#pragma unroll
                    for (int n = 0; n < 2; ++n) acc[a][b][m][n] = (f32x4){0.f, 0.f, 0.f, 0.f};
        cur = nxt; cB = nB; ++ui;
#pragma unroll
        for (int _h = 0; _h < 2; ++_h)
#pragma unroll
            for (int _i = 0; _i < 2; ++_i) oa[_h][_i] = na[_h][_i];
        if constexpr (GATHER) { nxt = nn; nB = nnB; has_next = has_nn;
#pragma unroll
            for (int _h = 0; _h < 2; ++_h)
#pragma unroll
                for (int _i = 0; _i < 2; ++_i) na[_h][_i] = nna[_h][_i]; }
        if (wr == 1) PG8_BAR;
    }
    PG8_WAIT_V(0);
    PG8_BAR;
#undef PG8_SA
#undef PG8_SB
#undef PG8_STAGE
#undef PG8_LDA
#undef PG8_LDB
#undef PG8_MMA
#undef PG8_WAIT_V
#undef PG8_WAIT_L
#undef PG8_BAR
#undef PG8_SCHED
#undef PG8_AOFFS
}

}
struct Args { const float* in[33]; float* out; unsigned char* ws; int ph_lo, ph_hi, row0, nrows, layer, pad; };
enum { IN_X = 0, IN_C, IN_CTX, IN_CCTX, IN_ADAW, IN_ADAB, IN_N1G, IN_N2G, IN_ABWIN, IN_CONVW, IN_CONVB, IN_CLNG, IN_CLNB, IN_QNG, IN_KNG, IN_LQ1, IN_LK1, IN_LQ2, IN_LK2,
       IN_SUBLN, IN_ABWOUT, IN_GLAWIN, IN_GLAWA2, IN_GLABA2, IN_GLANG, IN_GLAWOUT, IN_RGW, IN_RGB, IN_REW, IN_REB, IN_W1, IN_W3, IN_W2 };
enum { P_PRO_A = 0, P_PRO_B, P_INL0, P_ATT, P_OUTL0, P_ROUTE0, P_UP0, P_DOWN0, P_COMB0, P_INL1, P_GPREP, P_GSCAN, P_GOUT, P_OUTL1, P_ROUTE1, P_UP1, P_DOWN1, P_COMB1, P_COUNT };

struct Frame {
    LAS unsigned char* lds; int tid, lane, wave, G, bid;
};

constexpr size_t MiB = 1u << 20;
constexpr size_t FW_MODS = 0;
constexpr size_t FW_ROPE = 256 * 1024;
constexpr size_t FW_SCAL = FW_ROPE + 64 * 1024;
constexpr size_t FW_CTL = 512 * 1024;
constexpr size_t FW_WIN0 = 1 * MiB;
constexpr size_t FW_WOUT0 = 6 * MiB;
constexpr size_t FW_WIN1 = 8 * MiB;
constexpr size_t FW_WOUT1 = 15 * MiB;
constexpr size_t FW_W13 = 17 * MiB;
constexpr size_t FW_W2 = 81 * MiB;
constexpr size_t FW_HC = 113 * MiB;
constexpr size_t FW_RA = 115 * MiB, FW_RB = 180 * MiB, FW_RC = 310 * MiB, FW_RD = 440 * MiB, FW_RE = 450 * MiB, FW_RF = 515 * MiB, FW_END = 580 * MiB;

template <bool F8 = false, bool IL = false, class Src>
__device__ __forceinline__ void conv_item(const float* W, int ldw, bf16_t* Bt, int K, int k0, int j0, Src src, LAS float* scr, int lane, float scale = 1.f, int ioff = 0) {
    const int kr = lane >> 4, g = lane & 15; const int sc = src(j0 + 4 * g);
    f32x4 v[16];
#pragma unroll
    for (int i = 0; i < 16; ++i) v[i] = sc >= 0 ? *(const f32x4*)(W + (size_t)(k0 + 4 * i + kr) * ldw + sc) : (f32x4){0.f, 0.f, 0.f, 0.f};
#pragma unroll
    for (int i = 0; i < 16; ++i) { LAS float* d = scr + (4 * i + kr) * 65 + 4 * g; d[0] = v[i].x; d[1] = v[i].y; d[2] = v[i].z; d[3] = v[i].w; }
    asm volatile("s_waitcnt lgkmcnt(0)" ::: "memory");
    const int c = lane & 7, nr = lane >> 3;
#pragma unroll
    for (int jx = 0; jx < 8; ++jx) { const int n = nr + 8 * jx; const LAS float* s = scr + (8 * c) * 65 + n;
        if constexpr (F8) { int w0 = 0, w1 = 0; w0 = __builtin_amdgcn_cvt_pk_fp8_f32(s[0 * 65] * scale, s[1 * 65] * scale, w0, false); w0 = __builtin_amdgcn_cvt_pk_fp8_f32(s[2 * 65] * scale, s[3 * 65] * scale, w0, true);
            w1 = __builtin_amdgcn_cvt_pk_fp8_f32(s[4 * 65] * scale, s[5 * 65] * scale, w1, false); w1 = __builtin_amdgcn_cvt_pk_fp8_f32(s[6 * 65] * scale, s[7 * 65] * scale, w1, true);
            const int dr = IL ? j0 + ((n >> 2) << 3) + (n & 3) + ioff : j0 + n;
            u32x2 o; o.x = (unsigned)w0; o.y = (unsigned)w1; *(u32x2*)((unsigned char*)Bt + (size_t)dr * K + k0 + 8 * c) = o; }
        else { u32x4 o; o.x = cvtpk(s[0 * 65], s[1 * 65]); o.y = cvtpk(s[2 * 65], s[3 * 65]); o.z = cvtpk(s[4 * 65], s[5 * 65]); o.w = cvtpk(s[6 * 65], s[7 * 65]);
            *(u32x4*)(Bt + (size_t)(j0 + n) * K + k0 + 8 * c) = o; } }
    asm volatile("s_waitcnt lgkmcnt(0)" ::: "memory");
}
struct SrcWin0 {
    __device__ __forceinline__ int operator()(int j) const {
        const int pn = j >> 8, jl = j & 255;
        if (pn < 4) return (jl < 128) ? (128 * pn + jl) : (512 + 128 * pn + (jl - 128));
        if (pn < 8) { const int T = pn - 4, bj = jl >> 7, wc = (jl >> 5) & 3, fq = (jl >> 3) & 3, n = (jl >> 2) & 1, e = jl & 3;
            const int group = 4 * (T & 1) + wc, logical = bj * 32 + n * 16 + 4 * fq + e; return (T < 2 ? 1024 : 1536) + group * 64 + logical; }
        return j;
    }
};
struct SrcIdent { __device__ __forceinline__ int operator()(int j) const { return j; } };
struct SrcWin1 { __device__ __forceinline__ int operator()(int j) const { return j < 3104 ? j : -1; } };

__device__ __forceinline__ void phase_pro_a(const Frame& F, const Args& a) {
    float* mods = (float*)(a.ws + FW_MODS);
    if (F.bid < 192) {
        LAS float* s = (LAS float*)F.lds;
        LAS float* part = s + 3 * 1024;
        for (int i = F.tid; i < 3 * 1024; i += NTHR) { const int r = i >> 10, k = i & 1023; const float v = r < 2 ? a.in[IN_C][r * 1024 + k] : a.in[IN_CCTX][k]; s[i] = v / (1.f + expf(-v)); }
        __syncthreads();
        const int col = F.bid * 64 + F.lane;
        const int l = col / 6144, j = col % 6144;
        const float* w = a.in[IN_ADAW] + (size_t)l * 1024 * 6144 + j + (size_t)(F.wave * 128) * 6144;
        float a0 = 0.f, a1 = 0.f, a2 = 0.f;
#pragma unroll 64
        for (int k = 0; k < 128; ++k) { const float wv = w[(size_t)k * 6144]; const int kk = F.wave * 128 + k; a0 += s[kk] * wv; a1 += s[1024 + kk] * wv; a2 += s[2048 + kk] * wv; }
        part[(F.wave * 3 + 0) * 64 + F.lane] = a0; part[(F.wave * 3 + 1) * 64 + F.lane] = a1; part[(F.wave * 3 + 2) * 64 + F.lane] = a2;
        __syncthreads();
        if (F.tid < 192) { const int r = F.tid >> 6, ln = F.tid & 63; float acc = 0.f;
#pragma unroll
            for (int wv = 0; wv < 8; ++wv) acc += part[(wv * 3 + r) * 64 + ln];
            const int c2 = F.bid * 64 + ln; const int l2 = c2 / 6144, j2 = c2 % 6144;
            mods[(l2 * 3 + r) * 6144 + j2] = acc + a.in[IN_ADAB][l2 * 6144 + j2]; }
        __syncthreads();
    }
    if (F.bid >= 192 && F.bid < 200) {
        const int idx = (F.bid - 192) * NTHR + F.tid;
        const int pos = idx >> 4, i = idx & 15;
        const float inv = powf(10000.f, -(float)(2 * i) / 32.f); float sn, cs; sincosf((float)pos * inv, &sn, &cs);
        ((float2*)(a.ws + FW_ROPE))[idx] = make_float2(cs, sn);
    }
    if (F.bid == 200 && F.wave == 0) {
        float x = a.in[IN_LQ1][F.lane] * a.in[IN_LK1][F.lane], y = a.in[IN_LQ2][F.lane] * a.in[IN_LK2][F.lane];
        x = wave_sum(x); y = wave_sum(y);
        if (F.lane == 0) ((float*)(a.ws + FW_SCAL))[0] = expf(x) - expf(y) + 0.2f;
        float gq = fabsf(a.in[IN_QNG][F.lane]), gk = fabsf(a.in[IN_KNG][F.lane]);
#pragma unroll
        for (int o = 1; o < 64; o <<= 1) { gq = fmaxf(gq, __shfl_xor(gq, o)); gk = fmaxf(gk, __shfl_xor(gk, o)); }
        if (F.lane == 0) ((float*)(a.ws + FW_SCAL))[1] = exp2f(ceilf(fmaxf(0.f, 64.f * gq * gk * QSCALE - 8.5f)));
    }
    LAS float* scr = (LAS float*)(F.lds + F.wave * 16640);
    const int gw = F.bid * NWAVES + F.wave, NGW = F.G * NWAVES;
    constexpr int I_WIN0 = (2560 / 64) * (1024 / 64), I_WOUT0 = (1024 / 64) * (1024 / 64), I_WIN1 = (3328 / 64) * (1024 / 64);
    for (int it = gw; it < I_WIN0 + 2 * I_WOUT0 + I_WIN1; it += NGW) {
        int r = it;
        if (r < I_WIN0) { conv_item(a.in[IN_ABWIN], 2560, (bf16_t*)(a.ws + FW_WIN0), 1024, (r & 15) * 64, (r >> 4) * 64, SrcWin0{}, scr, F.lane); continue; } r -= I_WIN0;
        if (r < I_WOUT0) { conv_item(a.in[IN_ABWOUT], 1024, (bf16_t*)(a.ws + FW_WOUT0), 1024, (r & 15) * 64, (r >> 4) * 64, SrcIdent{}, scr, F.lane); continue; } r -= I_WOUT0;
        if (r < I_WOUT0) { conv_item(a.in[IN_GLAWOUT], 1024, (bf16_t*)(a.ws + FW_WOUT1), 1024, (r & 15) * 64, (r >> 4) * 64, SrcIdent{}, scr, F.lane); continue; } r -= I_WOUT0;
        conv_item(a.in[IN_GLAWIN], 3104, (bf16_t*)(a.ws + FW_WIN1), 1024, (r & 15) * 64, (r >> 4) * 64, SrcWin1{}, scr, F.lane);
    }
}

__device__ __forceinline__ void norm_mod_row(const float* h, const float* g, const float* msh, const float* msc, bf16_t* o, int lane) {
    const f32x4* hr = (const f32x4*)h + lane;
    f32x4 v[4]; float ss = 0.f;
#pragma unroll
    for (int j = 0; j < 4; ++j) { v[j] = hr[64 * j]; ss += (v[j].x * v[j].x + v[j].y * v[j].y) + (v[j].z * v[j].z + v[j].w * v[j].w); }
    const float rs = rsqrtf(wave_sum(ss) * (1.f / D) + EPS);
    u32x2* o8 = (u32x2*)o + lane;
#pragma unroll
    for (int j = 0; j < 4; ++j) { const int c = 4 * lane + 256 * j; const f32x4 gg = *(const f32x4*)(g + c), sh = *(const f32x4*)(msh + c), sc = *(const f32x4*)(msc + c);
        const f32x4 y = v[j] * rs * gg * (sc + 1.f) + sh; u32x2 w; w.x = cvtpk(y.x, y.y); w.y = cvtpk(y.z, y.w); o8[64 * j] = w; }
}
__device__ __forceinline__ void phase_pro_b(const Frame& F, const Args& a, bf16_t* N) {
    const float* mods = (const float*)(a.ws + FW_MODS);
    const int gw = F.bid * NWAVES + F.wave, NGW = F.G * NWAVES;
    for (int r = gw; r < a.nrows; r += 2 * NGW) {
        const int r2 = r + NGW; const bool two = r2 < a.nrows;
        const int rg = a.row0 + r, b = rg / ROWS, p = rg % ROWS; const int rgb = a.row0 + (two ? r2 : r), bb = rgb / ROWS, pb = rgb % ROWS;
        const float* h = p < CTX ? a.in[IN_CTX] + ((size_t)b * CTX + p) * D : a.in[IN_X] + ((size_t)b * SEQ + (p - CTX)) * D;
        const float* h2 = pb < CTX ? a.in[IN_CTX] + ((size_t)bb * CTX + pb) * D : a.in[IN_X] + ((size_t)bb * SEQ + (pb - CTX)) * D;
        const f32x4* hr = (const f32x4*)h + F.lane; const f32x4* hr2 = (const f32x4*)h2 + F.lane;
        f32x4 v[4], w[4]; float ss = 0.f, s2 = 0.f;
#pragma unroll
        for (int j = 0; j < 4; ++j) { v[j] = hr[64 * j]; w[j] = hr2[64 * j]; }
#pragma unroll
        for (int j = 0; j < 4; ++j) { ss += (v[j].x * v[j].x + v[j].y * v[j].y) + (v[j].z * v[j].z + v[j].w * v[j].w); s2 += (w[j].x * w[j].x + w[j].y * w[j].y) + (w[j].z * w[j].z + w[j].w * w[j].w); }
        const float rs = rsqrtf(wave_sum(ss) * (1.f / D) + EPS), rs2 = rsqrtf(wave_sum(s2) * (1.f / D) + EPS);
        const float* m = mods + (size_t)(p < CTX ? 2 : b) * 6144; const float* m2 = mods + (size_t)(pb < CTX ? 2 : bb) * 6144; const float* g = a.in[IN_N1G];
        u32x2* o8 = (u32x2*)(N + (size_t)r * D) + F.lane; u32x2* o82 = (u32x2*)(N + (size_t)(two ? r2 : r) * D) + F.lane;
#pragma unroll
        for (int j = 0; j < 4; ++j) { const int c = 4 * F.lane + 256 * j; const f32x4 gg = *(const f32x4*)(g + c);
            { const f32x4 sh = *(const f32x4*)(m + c), sc = *(const f32x4*)(m + 1024 + c); const f32x4 y = v[j] * rs * gg * (sc + 1.f) + sh; u32x2 q; q.x = cvtpk(y.x, y.y); q.y = cvtpk(y.z, y.w); o8[64 * j] = q; }
            if (two) { const f32x4 sh = *(const f32x4*)(m2 + c), sc = *(const f32x4*)(m2 + 1024 + c); const f32x4 y = w[j] * rs2 * gg * (sc + 1.f) + sh; u32x2 q; q.x = cvtpk(y.x, y.y); q.y = cvtpk(y.z, y.w); o82[64 * j] = q; } }
    }
}

struct EpiInL0 {
    static constexpr bool PERM = true; static constexpr bool FP8 = false;
    bf16_t *HH, *Q, *Kb, *V; const float* qn_g; const float* kn_g; const float2* rope; int rowbase;
    __device__ __forceinline__ void operator()(const f32x4 (&acc)[2][2][4][2], const pg8::Unit& u, int wr, int wc, int fr, int fq) const {
        const int pn = u.pn;
        asm volatile("" : "+v"(fr), "+v"(fq));
        if (pn < 4) {
#pragma unroll
            for (int ai = 0; ai < 2; ++ai)
#pragma unroll
                for (int m = 0; m < 4; ++m) { const int row = u.pm * 256 + ai * 128 + wr * 64 + m * 16 + fr;
                    float h[8];
#pragma unroll
                    for (int n = 0; n < 2; ++n)
#pragma unroll
                        for (int e = 0; e < 4; ++e) h[n * 4 + e] = acc[ai][0][m][n][e] * fsigmoid(acc[ai][1][m][n][e]);
                    u32x4 w; w.x = cvtpk(h[0], h[1]); w.y = cvtpk(h[2], h[3]); w.z = cvtpk(h[4], h[5]); w.w = cvtpk(h[6], h[7]);
                    *(u32x4*)(HH + (size_t)row * 512 + pn * 128 + wc * 32 + 8 * fq) = w; }
        } else if (pn < 8) {
            const bool isq = pn < 6; const int group = 4 * ((pn - 4) & 1) + wc;
            const float* gp = isq ? qn_g : kn_g; unsigned char* dst = (unsigned char*)(isq ? Q : Kb);
            const int p0 = (rowbase + u.pm * 256) % ROWS; const bool latent = p0 >= CTX;
            f32x4 gA[2], gB[2], rA[2][2];
#pragma unroll
            for (int bj = 0; bj < 2; ++bj) { gA[bj] = *(const f32x4*)(gp + bj * 32 + 4 * fq); gB[bj] = *(const f32x4*)(gp + bj * 32 + 16 + 4 * fq); }
            if (latent) {
#pragma unroll
                for (int ai = 0; ai < 2; ++ai) { const f32x4* rp = (const f32x4*)(rope + ((p0 - CTX + ai * 128 + wr * 64) >> 6) * 16 + 4 * fq); rA[ai][0] = rp[0]; rA[ai][1] = rp[1]; }
 }
#pragma unroll
            for (int m = 0; m < 4; ++m) { f32x4 rB0 = {0.f, 0.f, 0.f, 0.f}, rB1 = rB0;
                if (latent) { const f32x4* rp = (const f32x4*)(rope + (m * 16 + fr) * 16 + 4 * fq); rB0 = rp[0]; rB1 = rp[1]; }
#pragma unroll
                for (int ai = 0; ai < 2; ++ai) { const int rl = ai * 128 + wr * 64 + m * 16 + fr; const int row = u.pm * 256 + rl;
                    float ss = 0.f;
#pragma unroll
                    for (int bj = 0; bj < 2; ++bj)
#pragma unroll
                        for (int n = 0; n < 2; ++n)
#pragma unroll
                            for (int e = 0; e < 4; ++e) { const float x = acc[ai][bj][m][n][e]; ss += x * x; }
                    ss = xor32_sum(xor16_sum(ss));
                    const float rs = rsqrtf(ss * (1.f / 64.f) + EPS) * (isq ? QSCALE : 1.f);
                    u32x4 w8;
#pragma unroll
                    for (int bj = 0; bj < 2; ++bj) { float y0[4], y1[4];
                        const f32x4 g0 = gA[bj], g1 = gB[bj];
#pragma unroll
                        for (int e = 0; e < 4; ++e) { y0[e] = acc[ai][bj][m][0][e] * rs * g0[e]; y1[e] = acc[ai][bj][m][1][e] * rs * g1[e]; }
                        if (latent) { const f32x4 c01 = bj ? rB0 : rA[ai][0], c23 = bj ? rB1 : rA[ai][1];
                            const float cs[4] = {c01.x, c01.z, c23.x, c23.z}, sn[4] = {c01.y, c01.w, c23.y, c23.w};
#pragma unroll
                            for (int e = 0; e < 4; ++e) { const float a0 = y0[e], a1 = y1[e]; y0[e] = a0 * cs[e] - a1 * sn[e]; y1[e] = a1 * cs[e] + a0 * sn[e]; } }
                        int wa = 0, wb = 0; wa = __builtin_amdgcn_cvt_pk_fp8_f32(y0[0], y0[1], wa, false); wa = __builtin_amdgcn_cvt_pk_fp8_f32(y0[2], y0[3], wa, true);
                        wb = __builtin_amdgcn_cvt_pk_fp8_f32(y1[0], y1[1], wb, false); wb = __builtin_amdgcn_cvt_pk_fp8_f32(y1[2], y1[3], wb, true);
                        if (bj == 0) { w8.x = (unsigned)wa; w8.y = (unsigned)wb; } else { w8.z = (unsigned)wa; w8.w = (unsigned)wb; } }
                    *(u32x4*)(dst + (size_t)row * 512 + group * 64 + 16 * fq) = w8; } }
        } else {
            unsigned char* V8 = (unsigned char*)V;
#pragma unroll
            for (int ai = 0; ai < 2; ++ai) { const int tile = (rowbase + u.pm * 256 + ai * 128 + wr * 64) >> 6;
#pragma unroll
                for (int bj = 0; bj < 2; ++bj) { unsigned char* blk = V8 + ((size_t)tile * 4 + (pn - 8) * 2 + bj) * 8192;
#pragma unroll
                    for (int n = 0; n < 2; ++n) { const int cofs = (((fr >> 2) ^ ((2 * fq + n) & 3)) << 4) + ((fr & 3) << 2);
#pragma unroll
                        for (int e = 0; e < 4; ++e) { const int dv = wc * 32 + 8 * fq + 4 * n + e;
                            int w = 0; w = __builtin_amdgcn_cvt_pk_fp8_f32(acc[ai][bj][0][n][e], acc[ai][bj][1][n][e], w, false); w = __builtin_amdgcn_cvt_pk_fp8_f32(acc[ai][bj][2][n][e], acc[ai][bj][3][n][e], w, true);
                            *(int*)(blk + dv * 64 + cofs) = w; } } } }
        }
    }
};
namespace att {
typedef short s16x4 __attribute__((ext_vector_type(4)));
constexpr int QBLK = 32, KVBLK = 64, LDQ = 512, LDK = 512;
#define KSWZ(row, colB) ((row) * 256 + ((colB) ^ (((row) & 7) << 4)))
#define SBAR() __builtin_amdgcn_sched_barrier(0)
__device__ __forceinline__ int crow(int r, int hi) { return (r & 3) + 8 * (r >> 2) + 4 * hi; }
__device__ __forceinline__ unsigned cvtpk_a(float lo, float hi) { unsigned r; asm volatile("v_cvt_pk_bf16_f32 %0, %1, %2" : "=v"(r) : "v"(lo), "v"(hi)); return r; }

typedef int v8i_t __attribute__((ext_vector_type(8)));
typedef short v2s_t __attribute__((ext_vector_type(2)));
__device__ __forceinline__ int krow_lds(int k) { return ((k & 4) << 3) + (k >> 4) + (((k >> 3) & 1) << 2) + ((k & 3) << 3); }
__device__ __forceinline__ int krow_key(int r) { return (((r >> 5) & 1) << 2) | ((r & 3) << 4) | (((r >> 2) & 1) << 3) | ((r >> 3) & 3); }
constexpr int SLOT = 16384, NS = 7, KOFF = 8192;
struct KFrag { u32x4 a0, a1, b0, b1; };
struct VFrag { u32x4 lo[4], hh[4]; };
__device__ __forceinline__ void k_read(KFrag& f, const char* S, int kofA, int kofB) {
  f.a0 = *reinterpret_cast<const u32x4*>(S + KOFF + kofA); f.a1 = *reinterpret_cast<const u32x4*>(S + KOFF + kofB);
  f.b0 = *reinterpret_cast<const u32x4*>(S + KOFF + 4096 + kofA); f.b1 = *reinterpret_cast<const u32x4*>(S + KOFF + 4096 + kofB);
}
__device__ __forceinline__ void v_read(VFrag& f, const char* S, int vofA, int vofB) {
#pragma unroll
  for (int d0 = 0; d0 < 4; ++d0) { f.lo[d0] = *reinterpret_cast<const u32x4*>(S + d0 * 2048 + vofA); f.hh[d0] = *reinterpret_cast<const u32x4*>(S + d0 * 2048 + vofB); }
}
__device__ __forceinline__ void qk_mma(f32x16& p0, f32x16& p1, const KFrag& f, const v8i_t& qr) {
  const v8i_t ka = {(int)f.a0.x, (int)f.a0.y, (int)f.a0.z, (int)f.a0.w, (int)f.a1.x, (int)f.a1.y, (int)f.a1.z, (int)f.a1.w};
  const v8i_t kb = {(int)f.b0.x, (int)f.b0.y, (int)f.b0.z, (int)f.b0.w, (int)f.b1.x, (int)f.b1.y, (int)f.b1.z, (int)f.b1.w};
  p0 = __builtin_amdgcn_mfma_scale_f32_32x32x64_f8f6f4(ka, qr, f32x16{}, 0, 0, 0, 0, 0, 0);
  p1 = __builtin_amdgcn_mfma_scale_f32_32x32x64_f8f6f4(kb, qr, f32x16{}, 0, 0, 0, 0, 0, 0);
}
__device__ __forceinline__ void pv_mma(f32x16* o, const VFrag& f, const v8i_t& pa) {
#pragma unroll
  for (int d0 = 0; d0 < 4; ++d0) {
    const v8i_t vb = {(int)f.lo[d0].x, (int)f.lo[d0].y, (int)f.lo[d0].z, (int)f.lo[d0].w, (int)f.hh[d0].x, (int)f.hh[d0].y, (int)f.hh[d0].z, (int)f.hh[d0].w};
    o[d0] = __builtin_amdgcn_mfma_scale_f32_32x32x64_f8f6f4(pa, vb, o[d0], 0, 0, 0, 0, 0, 0); }
}
__device__ __forceinline__ void soft_exp(f32x16& p) {
#pragma unroll
  for (int r = 0; r < 16; ++r) p[r] = __builtin_amdgcn_exp2f(p[r]);
}
__device__ __forceinline__ void soft_sum(const f32x16& p0, const f32x16& p1, float& l_reg) {
  float ps = p0[0];
#pragma unroll
  for (int r = 1; r < 16; ++r) ps += p0[r];
#pragma unroll
  for (int r = 0; r < 16; ++r) ps += p1[r];
  l_reg += ps;
}
template <int W0> __device__ __forceinline__ void soft_pack(const f32x16& p, float sc, v8i_t& pa) {
#pragma unroll
  for (int v = 0; v < 4; ++v) { int u_; asm volatile("" : "=v"(u_)); v2s_t w = __builtin_bit_cast(v2s_t, u_);

    w = __builtin_amdgcn_cvt_scalef32_pk_fp8_f32(w, p[4 * v], p[4 * v + 1], sc, false); w = __builtin_amdgcn_cvt_scalef32_pk_fp8_f32(w, p[4 * v + 2], p[4 * v + 3], sc, true); pa[W0 + v] = __builtin_bit_cast(int, w); }
}

__device__ __forceinline__ void attn_unit(const unsigned char* __restrict__ Q8b, const unsigned char* __restrict__ K8h, const unsigned char* __restrict__ V8h, bf16_t* __restrict__ Ob, int ldo,
                                          int seq, const float* __restrict__ subg, float lam, float psc, LAS unsigned char* ldsl) {
  char* lds = (char*)ldsl;
  int tid = threadIdx.x; asm volatile("" : "+v"(tid));
  const int wid = __builtin_amdgcn_readfirstlane(tid >> 6), lane = tid & 63, r32 = lane & 31, hi = lane >> 5;
  const int map = wid >> 2, qs = wid & 3, mapcol = map * 64;
  f32x16 o[4] = {}; v8i_t qr;
  asm volatile("s_waitcnt vmcnt(0)" ::: "memory");
  { const unsigned char* Qw = Q8b + (long)(qs * QBLK + r32) * 512 + mapcol + hi * 32;
    const u32x4 q0 = *reinterpret_cast<const u32x4*>(Qw), q1 = *reinterpret_cast<const u32x4*>(Qw + 16);
    qr = v8i_t{(int)q0.x, (int)q0.y, (int)q0.z, (int)q0.w, (int)q1.x, (int)q1.y, (int)q1.z, (int)q1.w}; }
  asm volatile("s_waitcnt vmcnt(0)" ::: "memory");
  const int kofA = r32 * 128 + (((map * 4 + 2 * hi) ^ ((r32 >> 1) & 7)) << 4), kofB = r32 * 128 + (((map * 4 + 2 * hi + 1) ^ ((r32 >> 1) & 7)) << 4);
  const int vofA = r32 * 64 + (((2 * hi) ^ ((r32 >> 2) & 3)) << 4), vofB = r32 * 64 + (((2 * hi + 1) ^ ((r32 >> 2) & 3)) << 4);
  const unsigned vsrc = (unsigned)tid * 16u, ksrc = (unsigned)(krow_key(tid >> 3) * 512 + (((tid & 7) ^ ((tid >> 4) & 7)) << 4));
  LAS unsigned char* const lw = ldsl + wid * 1024;
#define DMA(tl, sb) do { const int tl_ = (tl) < NT ? (tl) : NT - 1;        \
    __builtin_amdgcn_global_load_lds((const unsigned*)(V8h + (size_t)tl_ * 32768 + vsrc), (LAS unsigned*)(lw + (sb)), 16, 0, 0); \
    __builtin_amdgcn_global_load_lds((const unsigned*)(K8h + (size_t)tl_ * 32768 + ksrc), (LAS unsigned*)(lw + (sb) + KOFF), 16, 0, 0); } while (0)
#define NEXT(x) do { x += SLOT; if (x == NS * SLOT) x = 0; } while (0)
#define TBAR() do { asm volatile("s_waitcnt vmcnt(4)" ::: "memory"); __builtin_amdgcn_s_barrier(); } while (0)
#define H1(tl, S0, S1, WITHV) do { DMA((tl) + 4, dsl); NEXT(dsl); k_read(kf, lds + ksl, kofA, kofB); NEXT(ksl); if (WITHV) { v_read(vf, lds + vsl, vofA, vofB); NEXT(vsl); } \
    soft_exp(S0); soft_exp(S1); SBAR(); TBAR(); SBAR(); } while (0)
#define H2(S0, S1, N0, N1, PC, PP, WITHPV) do { qk_mma(N0, N1, kf, qr); if (WITHPV) { pv_mma(o, vf, PP); lacc = __builtin_amdgcn_mfma_scale_f32_32x32x64_f8f6f4(PP, ones, lacc, 0, 0, 0, 0, 0, 0); } soft_pack<0>(S0, psc, PC); soft_pack<4>(S1, psc, PC); SBAR(); TBAR(); } while (0)
  f32x16 sA0, sA1, sB0, sB1, lacc = {}; v8i_t pa0 = {}, pa1 = {}; KFrag kf; VFrag vf; const int NT = seq / KVBLK;
  const v8i_t ones = {0x38383838, 0x38383838, 0x38383838, 0x38383838, 0x38383838, 0x38383838, 0x38383838, 0x38383838};
  DMA(0, 0); DMA(1, SLOT); DMA(2, 2 * SLOT); DMA(3, 3 * SLOT);
  TBAR();
  int dsl = 4 * SLOT, ksl = SLOT, vsl = 0;
  k_read(kf, lds, kofA, kofB); qk_mma(sA0, sA1, kf, qr);
  if (map == 1) TBAR();
  H1(0, sA0, sA1, false); H2(sA0, sA1, sB0, sB1, pa0, pa1, false);
  for (int t = 1; t + 1 < NT; t += 2) {
    H1(t, sB0, sB1, true); H2(sB0, sB1, sA0, sA1, pa1, pa0, true);
    H1(t + 1, sA0, sA1, true); H2(sA0, sA1, sB0, sB1, pa0, pa1, true);
  }
  v_read(vf, lds + vsl, vofA, vofB); NEXT(vsl); soft_exp(sB0); soft_exp(sB1);
  SBAR(); pv_mma(o, vf, pa0); lacc = __builtin_amdgcn_mfma_scale_f32_32x32x64_f8f6f4(pa0, ones, lacc, 0, 0, 0, 0, 0, 0); soft_pack<0>(sB0, psc, pa1); soft_pack<4>(sB1, psc, pa1);
  SBAR(); v_read(vf, lds + vsl, vofA, vofB);
  SBAR(); pv_mma(o, vf, pa1); lacc = __builtin_amdgcn_mfma_scale_f32_32x32x64_f8f6f4(pa1, ones, lacc, 0, 0, 0, 0, 0, 0);
  if (map == 0) TBAR();
#undef DMA
#undef NEXT
#undef TBAR
#undef H1
#undef H2
  asm volatile("s_waitcnt vmcnt(0)" ::: "memory");
  __syncthreads();
  float* X = (float*)lds;
  int r32e = r32, hie = hi, qse = qs;
  asm volatile("" : "+v"(r32e), "+v"(hie), "+v"(qse));
  float rli[16];
#pragma unroll
  for (int r = 0; r < 16; ++r) rli[r] = __builtin_amdgcn_rcpf(lacc[r]) * (map ? -lam : 1.f);
  if (map == 1) {
#pragma unroll
    for (int r = 0; r < 16; ++r)
#pragma unroll
      for (int d0 = 0; d0 < 4; ++d0) X[(qse * 32 + crow(r, hie)) * 128 + d0 * 32 + r32e] = o[d0][r] * rli[r];
  }
  __syncthreads();
  if (map == 0) {
    float g4[4];
#pragma unroll
    for (int d0 = 0; d0 < 4; ++d0) g4[d0] = subg[d0 * 32 + r32e] * 0.8f;
#pragma unroll
    for (int r = 0; r < 16; ++r) { const int row = qse * 32 + crow(r, hie); float v[4]; float ss = 0.f;
#pragma unroll
      for (int d0 = 0; d0 < 4; ++d0) { v[d0] = o[d0][r] * rli[r] + X[row * 128 + d0 * 32 + r32e]; ss += v[d0] * v[d0]; }
      ss = half_sum32(ss);
      const float rs = rsqrtf(ss * (1.f / 128.f) + EPS);
#pragma unroll
      for (int d0 = 0; d0 < 4; ++d0) { const float y = v[d0] * rs * g4[d0]; Ob[(long)row * ldo + d0 * 32 + r32e] = (bf16_t)(cvtpk(y, y) & 0xffffu); } }
  }
  __syncthreads();
}
#undef KSWZ
#undef SBAR
}

__device__ __forceinline__ void conv_phase(const Frame& F, const Args& a, const bf16_t* HH, bf16_t* MIX, int row0, int nrows) {
    const int c = F.tid;
    float w[31];
#pragma unroll
    for (int j = 0; j < 31; ++j) w[j] = a.in[IN_CONVW][j * 512 + c];
    const float cb = a.in[IN_CONVB][c], lg = a.in[IN_CLNG][c], lb = a.in[IN_CLNB][c];
    LAS bf16_t* xs = (LAS bf16_t*)F.lds;
    LAS float* part = (LAS float*)(F.lds + 46 * 1024);
    LAS float* stat = part + 32 * 32;
    const int ntiles = nrows / 16;
    u32x4 pf[6];
#define CONV_FETCH(tt) do { const int r0_ = (tt) * 16; const int p_ = (row0 + r0_) % ROWS; \
        const int lo_ = (p_ < CTX) ? (r0_ - p_) : (r0_ - p_ + CTX), hi_ = (p_ < CTX) ? (r0_ - p_ + CTX) : (r0_ - p_ + ROWS); \
        _Pragma("unroll") for (int k_ = 0; k_ < 6; ++k_) { const int ch_ = F.tid + NTHR * k_; const int q_ = ch_ >> 6, cc_ = (ch_ & 63) * 8; const int rq_ = r0_ - 15 + q_; \
            u32x4 v_ = {0u, 0u, 0u, 0u}; if (ch_ < 46 * 64 && rq_ >= lo_ && rq_ < hi_) v_ = *(const u32x4*)(HH + (size_t)rq_ * 512 + cc_); pf[k_] = v_; } } while (0)
    if (F.bid < ntiles) CONV_FETCH(F.bid);
    for (int t = F.bid; t < ntiles; t += F.G) {
        const int r0 = t * 16;
        __syncthreads();
#pragma unroll
        for (int k = 0; k < 6; ++k) { const int ch = F.tid + NTHR * k; if (ch < 46 * 64) *(LAS u32x4*)(xs + (ch >> 6) * 512 + (ch & 63) * 8) = pf[k]; }
        __syncthreads();
        if (t + F.G < ntiles) CONV_FETCH(t + F.G);
        float out[16];
#pragma unroll
        for (int i = 0; i < 16; ++i) out[i] = cb;
#pragma unroll
        for (int q = 0; q < 46; ++q) { const float x = bf2f(xs[q * 512 + c]);
#pragma unroll
            for (int i = 0; i < 16; ++i) { const int j = q - i; if (j >= 0 && j <= 30) out[i] += x * w[j]; } }
#pragma unroll
        for (int i = 0; i < 16; ++i) { const float s1 = row_sum16(out[i]), s2 = row_sum16(out[i] * out[i]);
            if ((F.lane & 15) == 0) { part[(F.wave * 4 + (F.lane >> 4)) * 32 + i] = s1; part[(F.wave * 4 + (F.lane >> 4)) * 32 + 16 + i] = s2; } }
        __syncthreads();
        if (F.tid < 32) { float s = 0.f;
#pragma unroll
            for (int wv = 0; wv < 32; ++wv) s += part[wv * 32 + F.tid];
            stat[F.tid] = s; }
        __syncthreads();
#pragma unroll
        for (int i = 0; i < 16; ++i) { const float mean = stat[i] * (1.f / 512.f); const float var = stat[16 + i] * (1.f / 512.f) - mean * mean;
            const float y = (out[i] - mean) * rsqrtf(fmaxf(var, 0.f) + EPS) * lg + lb; const float z = y * fsigmoid(y);
            MIX[(size_t)(r0 + i) * 1024 + c] = (bf16_t)(cvtpk(z, z) & 0xffffu); }
    }
#undef CONV_FETCH
    __syncthreads();
}

__device__ __forceinline__ void attn_phase(const Frame& F, const Args& a, const unsigned char* Q8, const unsigned char* K8, const unsigned char* V8, bf16_t* MIX, int nrows) {
    const int nb = nrows / ROWS; const float lam = ((const float*)(a.ws + FW_SCAL))[0]; const float psc = ((const float*)(a.ws + FW_SCAL))[1];
    const int nlat = nb * 512, nctx = nb * 8;
#ifndef MK_ATTX
#define MK_ATTX 1
#endif
    for (int L0 = F.bid; L0 < (nlat + nctx) * MK_ATTX; L0 += F.G) { const int L = L0 % (nlat + nctx);
        int b, h, q0, seq;
        if (L < nlat) { b = L / 512; const int r = L % 512; h = r >> 7; q0 = CTX + (r & 127) * 128; seq = ROWS; }
        else { const int r = L - nlat; b = r >> 3; h = (r >> 1) & 3; q0 = (r & 1) * 128; seq = CTX; }
        const size_t rb = (size_t)b * ROWS;
        att::attn_unit(Q8 + (rb + q0) * 512 + h * 128, K8 + rb * 512 + h * 128, V8 + ((size_t)b * (ROWS / 64) * 4 + h) * 8192, MIX + (rb + q0) * 1024 + 512 + h * 128, 1024, seq, a.in[IN_SUBLN], lam, psc, F.lds);
    }
}

template <class TIN> struct EpiResid2 {
    static constexpr bool PERM = true; static constexpr bool FP8 = false;
    const TIN *Hl_in, *Hc_in; bf16_t *Hl_out, *Hc_out; const float* mods_l; int gate_idx; int rowbase;
    __device__ __forceinline__ void operator()(const f32x4 (&acc)[2][2][4][2], const pg8::Unit& u, int wr, int wc, int fr, int fq) const {
        asm volatile("" : "+v"(fr), "+v"(fq));
        const int rg0 = rowbase + u.pm * 256; const int b = rg0 / ROWS, p0 = rg0 % ROWS; const bool isctx = p0 < CTX;
        const TIN* hin = isctx ? Hc_in + (size_t)(b * CTX + p0) * D : Hl_in + (size_t)(b * SEQ + (p0 - CTX)) * D;
        bf16_t* hout = isctx ? Hc_out + (size_t)(b * CTX + p0) * D : Hl_out + (size_t)(b * SEQ + (p0 - CTX)) * D;
        const float* gate = mods_l + (size_t)(isctx ? 2 : b) * 6144 + gate_idx * 1024;
        const int col0 = u.pn * 256 + wc * 32 + 8 * fq;
#pragma unroll
        for (int bj = 0; bj < 2; ++bj) { const int col = col0 + bj * 128; const f32x4 g0 = *(const f32x4*)(gate + col), g1 = *(const f32x4*)(gate + col + 4);
#pragma unroll
            for (int ai = 0; ai < 2; ++ai) { f32x4 h0[4], h1[4];
#pragma unroll
                for (int m = 0; m < 4; ++m) { const size_t off = (size_t)(ai * 128 + wr * 64 + m * 16 + fr) * D + col;
                    if constexpr (sizeof(TIN) == 4) { h0[m] = *(const f32x4*)((const float*)hin + off); h1[m] = *(const f32x4*)((const float*)hin + off + 4); }
                    else { const u32x4 w = *(const u32x4*)((const bf16_t*)hin + off);
                        h0[m] = (f32x4){__uint_as_float(w.x << 16), __uint_as_float(w.x & 0xffff0000u), __uint_as_float(w.y << 16), __uint_as_float(w.y & 0xffff0000u)};
                        h1[m] = (f32x4){__uint_as_float(w.z << 16), __uint_as_float(w.z & 0xffff0000u), __uint_as_float(w.w << 16), __uint_as_float(w.w & 0xffff0000u)}; } }
#pragma unroll
                for (int m = 0; m < 4; ++m) { const size_t off = (size_t)(ai * 128 + wr * 64 + m * 16 + fr) * D + col;
                    const f32x4 y0 = h0[m] + g0 * acc[ai][bj][m][0], y1 = h1[m] + g1 * acc[ai][bj][m][1];
                    u32x4 w; w.x = cvtpk(y0.x, y0.y); w.y = cvtpk(y0.z, y0.w); w.z = cvtpk(y1.x, y1.y); w.w = cvtpk(y1.z, y1.w);
                    *(u32x4*)(hout + off) = w; } } }
    }
};
struct MoeBufs {
    int* cnt;
    int* tok;
    int* slot;
    float* gate;
    bf16_t* HB;
    bf16_t* YS;
    int cap, pad;
};
struct SrcLin { int a; __device__ __forceinline__ int operator()(int j) const { return j + a; } };
struct SrcW13 { __device__ __forceinline__ int operator()(int j) const { const int pn = j >> 8, jl = j & 255; return 128 * pn + (jl & 127); } };

constexpr float WSC = 32.f;
__device__ __forceinline__ void wmoe_item(const Args& a, int l, bf16_t* W13t, bf16_t* W2t, int it, LAS float* scr, int lane) {
    const float* w1 = a.in[IN_W1] + (size_t)l * 32 * 1024 * 512; const float* w3 = a.in[IN_W3] + (size_t)l * 32 * 1024 * 512; const float* w2 = a.in[IN_W2] + (size_t)l * 32 * 512 * 1024;
    const int e = it / 384, r = it % 384;
    if (r < 256) { const int h = r >> 7, kb = (r >> 3) & 15, mblk = r & 7;
        conv_item<true, true>((h ? w3 : w1) + (size_t)e * 1024 * 512, 512, (bf16_t*)((unsigned char*)W13t + (size_t)e * 1024 * 1024), 1024, kb * 64, 128 * mblk, SrcLin{-64 * mblk}, scr, lane, WSC, 4 * h); }
    else { const int r2 = r - 256, kb = r2 >> 4, nb = r2 & 15;
        conv_item<true>(w2 + (size_t)e * 512 * 1024, 1024, (bf16_t*)((unsigned char*)W2t + (size_t)e * 1024 * 512), 512, kb * 64, nb * 64, SrcIdent{}, scr, lane, WSC); }
}
constexpr int WMOE_ITEMS = 32 * 384;
__device__ __forceinline__ void phase_wmoe(const Frame& F, const Args& a, int l, bf16_t* W13t, bf16_t* W2t, int bid0 = 0, int nbid = 0, int it_lo = 0, int it_hi = WMOE_ITEMS) {
    LAS float* scr = (LAS float*)(F.lds + F.wave * 16640);
    const int gw = (F.bid - bid0) * NWAVES + F.wave, NGW = (nbid ? nbid : F.G) * NWAVES;
    for (int it = it_lo + gw; it < it_hi; it += NGW) wmoe_item(a, l, W13t, W2t, it, scr, F.lane);
}
__device__ __forceinline__ void drain_wmoe(const Frame& F, const Args& a, int l, bf16_t* W13t, bf16_t* W2t, unsigned* counter) {
    __syncthreads();
    LAS float* scr = (LAS float*)(F.lds + F.wave * 16640);
    for (;;) { unsigned it = 0; if (F.lane == 0) it = atomicAdd(counter, 1u); it = (unsigned)__builtin_amdgcn_readfirstlane((int)it);
        if (it >= (unsigned)WMOE_ITEMS) break; wmoe_item(a, l, W13t, W2t, (int)it, scr, F.lane); }
    __syncthreads();
}

struct HRows { bf16_t* Hl; bf16_t* Hc;
    __device__ __forceinline__ bf16_t* row(int rg) const { const int b = rg / ROWS, p = rg % ROWS; return p < CTX ? Hc + (size_t)(b * CTX + p) * D : Hl + (size_t)(b * SEQ + (p - CTX)) * D; } };
typedef float f32x2_t __attribute__((ext_vector_type(2)));
__device__ __forceinline__ f32x4 fp8x4(unsigned w) { const f32x2_t lo = __builtin_amdgcn_cvt_pk_f32_fp8((int)w, false), hi = __builtin_amdgcn_cvt_pk_f32_fp8((int)w, true); return (f32x4){lo.x, lo.y, hi.x, hi.y}; }
__device__ __forceinline__ f32x4 bf4(u32x2 w) { return (f32x4){__uint_as_float(w.x << 16), __uint_as_float(w.x & 0xffff0000u), __uint_as_float(w.y << 16), __uint_as_float(w.y & 0xffff0000u)}; }

constexpr int RT_XS = 1032;
constexpr int RT_PART = 66048, RT_LGT = RT_PART + 8 * 16 * 48 * 4, RT_DEC = RT_LGT + 2 * 16 * 40 * 4 + 512;
constexpr int RT_CNT = RT_DEC + 6 * 4096, RT_BASE = RT_CNT + 128, RT_PSUM = RT_BASE + 128;
__device__ __forceinline__ void phase_route(const Frame& F, const Args& a, int l, const HRows& H, bf16_t* N, const MoeBufs& mb, int row0, int nrows, bool latent_only, int* cntW) {
    constexpr int RW = 2, RB = 8 * RW;
    const float* mods = (const float*)(a.ws + FW_MODS) + (size_t)l * 3 * 6144;
    const float* g2 = a.in[IN_N2G] + l * D;
    const float* rgw = a.in[IN_RGW] + (size_t)l * 1024 * 4; const float* rgb = a.in[IN_RGB] + l * 4;
    const float* rew = a.in[IN_REW] + (size_t)l * 1024 * 32; const float* reb = a.in[IN_REB] + l * 32;
    LAS bf16_t* xh = (LAS bf16_t*)F.lds;
    LAS bf16_t* xl = xh + 16 * RT_XS;
    LAS float* part = (LAS float*)(F.lds + RT_PART);
    LAS float* lgt = (LAS float*)(F.lds + RT_LGT);
    bf16x8 wh[4][3], wl[4][3];
    { const int c = F.lane & 15, g = F.lane >> 4;
#pragma unroll
      for (int ks = 0; ks < 4; ++ks)
#pragma unroll
        for (int cb = 0; cb < 3; ++cb) { unsigned hw[4], lw[4];
#pragma unroll
            for (int e2 = 0; e2 < 4; ++e2) { float wv[2];
#pragma unroll
                for (int q = 0; q < 2; ++q) { const int k = 128 * F.wave + 32 * ks + 8 * g + 2 * e2 + q; wv[q] = (cb < 2) ? rew[k * 32 + 16 * cb + c] : ((c < 4) ? rgw[k * 4 + c] : 0.f); }
                hw[e2] = cvtpk(wv[0], wv[1]); lw[e2] = cvtpk(wv[0] - __uint_as_float(hw[e2] << 16), wv[1] - __uint_as_float(hw[e2] & 0xffff0000u)); }
            const u32x4 h4 = {hw[0], hw[1], hw[2], hw[3]}, l4 = {lw[0], lw[1], lw[2], lw[3]};
            wh[ks][cb] = *reinterpret_cast<const bf16x8*>(&h4); wl[ks][cb] = *reinterpret_cast<const bf16x8*>(&l4); } }
    const int nb = nrows / ROWS; const int neff = latent_only ? nb * SEQ : nrows;
    const int nit = (neff / RB + F.G - 1) / F.G;
    auto lrow = [&](int i_) -> int { return latent_only ? (i_ / SEQ) * ROWS + CTX + (i_ % SEQ) : i_; };
    u32x2 nv[RW][4];
#define RT_FETCH(it_) do { const int ib_ = ((it_) * F.G + F.bid) * RB; if ((it_) < nit && ib_ < neff) { _Pragma("unroll") for (int r_ = 0; r_ < RW; ++r_) { \
        const u32x2* hr_ = (const u32x2*)H.row(row0 + lrow(ib_ + F.wave * RW + r_)) + F.lane; _Pragma("unroll") for (int j_ = 0; j_ < 4; ++j_) nv[r_][j_] = hr_[64 * j_]; } } } while (0)
    RT_FETCH(0);
    LAS int* dec = (LAS int*)(F.lds + RT_DEC); LAS int* cntL = (LAS int*)(F.lds + RT_CNT);
    if (F.tid < 32) cntL[F.tid] = 0;
    int nact = 0;
#ifndef MK_ROUTEX
#define MK_ROUTEX 1
#endif
    for (int itx = 0; itx < nit * MK_ROUTEX; ++itx) { const int it = itx % nit;
        const int ib = (it * F.G + F.bid) * RB;
        const bool act = ib < neff;
        f32x4 v[RW][4];
#pragma unroll
        for (int r = 0; r < RW; ++r)
#pragma unroll
            for (int j = 0; j < 4; ++j) v[r][j] = bf4(nv[r][j]);
        RT_FETCH((itx + 1) % nit);
        if (act) {
#pragma unroll
            for (int r = 0; r < RW; ++r) { const int lr = lrow(ib + F.wave * RW + r); const int rg = row0 + lr, b = rg / ROWS, p = rg % ROWS;
                const float* m = mods + (size_t)(p < CTX ? 2 : b) * 6144;
                float ss = 0.f;
#pragma unroll
                for (int j = 0; j < 4; ++j) ss += (v[r][j].x * v[r][j].x + v[r][j].y * v[r][j].y) + (v[r][j].z * v[r][j].z + v[r][j].w * v[r][j].w);
                const float rs = rsqrtf(wave_sum(ss) * (1.f / D) + EPS);
                unsigned* o8 = (unsigned*)((unsigned char*)N + (size_t)lr * D) + F.lane;
#pragma unroll
                for (int j = 0; j < 4; ++j) { const int c = 4 * F.lane + 256 * j; const f32x4 gg = *(const f32x4*)(g2 + c), sh = *(const f32x4*)(m + 3 * 1024 + c), sc = *(const f32x4*)(m + 4 * 1024 + c);
                    const f32x4 y = v[r][j] * rs * gg * (sc + 1.f) + sh; u32x2 w; w.x = cvtpk(y.x, y.y); w.y = cvtpk(y.z, y.w);
                    { int q8 = 0; q8 = __builtin_amdgcn_cvt_pk_fp8_f32(y.x, y.y, q8, false); q8 = __builtin_amdgcn_cvt_pk_fp8_f32(y.z, y.w, q8, true); o8[64 * j] = (unsigned)q8; }
                    u32x2 lo; lo.x = cvtpk(y.x - __uint_as_float(w.x << 16), y.y - __uint_as_float(w.x & 0xffff0000u)); lo.y = cvtpk(y.z - __uint_as_float(w.y << 16), y.w - __uint_as_float(w.y & 0xffff0000u));
                    *(LAS u32x2*)(xh + (F.wave * RW + r) * RT_XS + c) = w; *(LAS u32x2*)(xl + (F.wave * RW + r) * RT_XS + c) = lo; } }
        }
        __syncthreads();
        LAS float* lg = lgt + (it & 1) * RB * 40;
        if (act) {
            f32x4 acc0 = {0.f, 0.f, 0.f, 0.f}, acc1 = acc0, acc2 = acc0;
            const int xo = (F.lane & 15) * RT_XS + 128 * F.wave + 8 * (F.lane >> 4);
#pragma unroll
            for (int ks = 0; ks < 4; ++ks) { const bf16x8 ah = *(const LAS bf16x8*)(xh + xo + 32 * ks), al = *(const LAS bf16x8*)(xl + xo + 32 * ks);
                acc0 = __builtin_amdgcn_mfma_f32_16x16x32_bf16(ah, wh[ks][0], acc0, 0, 0, 0); acc1 = __builtin_amdgcn_mfma_f32_16x16x32_bf16(ah, wh[ks][1], acc1, 0, 0, 0); acc2 = __builtin_amdgcn_mfma_f32_16x16x32_bf16(ah, wh[ks][2], acc2, 0, 0, 0);
                acc0 = __builtin_amdgcn_mfma_f32_16x16x32_bf16(ah, wl[ks][0], acc0, 0, 0, 0); acc1 = __builtin_amdgcn_mfma_f32_16x16x32_bf16(ah, wl[ks][1], acc1, 0, 0, 0); acc2 = __builtin_amdgcn_mfma_f32_16x16x32_bf16(ah, wl[ks][2], acc2, 0, 0, 0);
                acc0 = __builtin_amdgcn_mfma_f32_16x16x32_bf16(al, wh[ks][0], acc0, 0, 0, 0); acc1 = __builtin_amdgcn_mfma_f32_16x16x32_bf16(al, wh[ks][1], acc1, 0, 0, 0); acc2 = __builtin_amdgcn_mfma_f32_16x16x32_bf16(al, wh[ks][2], acc2, 0, 0, 0); }
            LAS float* pw = part + F.wave * (16 * 48) + (4 * (F.lane >> 4)) * 48 + (F.lane & 15);
#pragma unroll
            for (int r = 0; r < 4; ++r) { pw[r * 48] = acc0[r]; pw[r * 48 + 16] = acc1[r]; pw[r * 48 + 32] = acc2[r]; }
        }
        __syncthreads();
        if (act) { const int row = F.tid >> 5, c = F.tid & 31; float s = 0.f, sg = 0.f;
#pragma unroll
            for (int w = 0; w < 8; ++w) { s += part[w * (16 * 48) + row * 48 + c]; if (c < 4) sg += part[w * (16 * 48) + row * 48 + 32 + c]; }
            lg[row * 40 + c] = s; if (c < 4) lg[row * 40 + 32 + c] = sg; }
        __syncthreads();
        if (act && F.tid < RB && itx < nit) { const LAS float* L = lg + F.tid * 40;
            const int row = lrow(ib + F.tid);
            const float lg0 = L[32] + rgb[0], lg1 = L[33] + rgb[1], lg2 = L[34] + rgb[2], lg3 = L[35] + rgb[3];
            int gi = 0; float bm = lg0;
            if (lg1 > bm) { bm = lg1; gi = 1; }
            if (lg2 > bm) { bm = lg2; gi = 2; }
            if (lg3 > bm) { bm = lg3; gi = 3; }
            const float pgs = __builtin_amdgcn_rcpf(__builtin_amdgcn_exp2f((lg0 - bm) * LOG2E) + __builtin_amdgcn_exp2f((lg1 - bm) * LOG2E) + __builtin_amdgcn_exp2f((lg2 - bm) * LOG2E) + __builtin_amdgcn_exp2f((lg3 - bm) * LOG2E));
            int i0 = 0; float v0 = L[gi * 8] + reb[gi * 8];
            for (int j = 1; j < 8; ++j) { const float x = L[gi * 8 + j] + reb[gi * 8 + j]; if (x > v0) { v0 = x; i0 = j; } }
            int i1 = -1; float v1 = -3.0e38f;
            for (int j = 0; j < 8; ++j) { const float x = L[gi * 8 + j] + reb[gi * 8 + j]; if (j != i0 && x > v1) { v1 = x; i1 = j; } }
            const float e1 = __builtin_amdgcn_exp2f((v1 - v0) * LOG2E); const float r1 = pgs * __builtin_amdgcn_rcpf(1.f + e1); const float g0 = r1, g1 = r1 * e1;
            const int ea = gi * 8 + i0, eb = gi * 8 + i1; const int di = it * RB + F.tid;
            const int pa = __hip_atomic_fetch_add(&cntL[ea], 1, __ATOMIC_RELAXED, __HIP_MEMORY_SCOPE_WORKGROUP), pb = __hip_atomic_fetch_add(&cntL[eb], 1, __ATOMIC_RELAXED, __HIP_MEMORY_SCOPE_WORKGROUP);
            dec[di] = row; dec[1024 + di] = ea | (eb << 8); dec[2048 + di] = pa; dec[3072 + di] = pb;
            dec[4096 + di] = __float_as_int(g0); dec[5120 + di] = __float_as_int(g1);
        }
        if (act && itx < nit) nact = it + 1;
    }
    __syncthreads();
    if (F.tid < 32) cntW[F.bid * 32 + F.tid] = cntL[F.tid];
    if (F.tid == 0) ((LAS int*)(F.lds + RT_PSUM))[16 * 32] = nact * RB;
#undef RT_FETCH
    __syncthreads();
}

__device__ __forceinline__ void phase_route_scatter(const Frame& F, const MoeBufs& mb, const int* cntW) {
    LAS int* dec = (LAS int*)(F.lds + RT_DEC); LAS int* base = (LAS int*)(F.lds + RT_BASE); LAS int* psum = (LAS int*)(F.lds + RT_PSUM);
    const int e = F.tid & 31, part = F.tid >> 5, PS = (F.G + 15) / 16;
    { int s = 0, sb = 0; const int w0 = part * PS, w1 = (w0 + PS < F.G) ? w0 + PS : F.G;
      for (int w = w0; w < w1; ++w) { const int c = cntW[w * 32 + e]; if (w < F.bid) sb += c; s += c; }
      psum[part * 32 + e] = s; psum[17 * 32 + part * 32 + e] = sb; }
    __syncthreads();
    if (F.tid < 32) { int tot = 0, b = 0;
#pragma unroll
        for (int p = 0; p < 16; ++p) { tot += psum[p * 32 + F.tid]; b += psum[17 * 32 + p * 32 + F.tid]; }
        base[F.tid] = b; if (F.bid == 0) mb.cnt[F.tid] = tot; }
    __syncthreads();
    const int ndec = psum[16 * 32];
    for (int di = F.tid; di < ndec; di += NTHR) { const int row = dec[di], ee = dec[1024 + di], ea = ee & 255, eb = ee >> 8, pa = base[ea] + dec[2048 + di], pb = base[eb] + dec[3072 + di];
        mb.tok[(size_t)ea * mb.cap + pa] = row; mb.slot[(size_t)ea * mb.cap + pa] = row * 2; mb.gate[(size_t)ea * mb.cap + pa] = __int_as_float(dec[4096 + di]);
        mb.tok[(size_t)eb * mb.cap + pb] = row; mb.slot[(size_t)eb * mb.cap + pb] = row * 2 + 1; mb.gate[(size_t)eb * mb.cap + pb] = __int_as_float(dec[5120 + di]); }
    __syncthreads();
}

struct MoeOrder {
    int G, c, total; const LAS int* pre;
    int lg = 2;
    __device__ __forceinline__ bool next(int i, pg8::Unit& u) const {
        int blk, pn;
        if ((G & 7) == 0) {
            const int x = c & 7, li = i * (G >> 3) + (c >> 3), bl = li >> lg, base = total >> 3, rem = total & 7;
            if (bl >= base + (x < rem ? 1 : 0)) return false;
            blk = x * base + (x < rem ? x : rem) + bl; pn = li & ((1 << lg) - 1);
        } else {
            const long L = (long)i * G + c; if (L >= ((long)total << lg)) return false;
            blk = (int)(L >> lg); pn = (int)(L & ((1 << lg) - 1));
        }
        const int e = pre[40 + blk];
        u.pm = blk; u.pn = pn; u.e = e; u.j = blk - pre[e]; return true;
    }
};
__device__ __forceinline__ int moe_order_init(const Frame& F, const int* cnt, LAS int* pre) {
    __syncthreads();
    if (F.tid == 0) { int s = 0; for (int e = 0; e < 32; ++e) { pre[e] = s; s += (cnt[e] + 255) >> 8; } pre[32] = s; }
    __syncthreads();
    const int total = pre[32];
    for (int blk = F.tid; blk < total; blk += NTHR) { int e = 0; while (pre[e + 1] <= blk) ++e; pre[40 + blk] = e; }
    __syncthreads();
    return total;
}
#ifndef MK_KX
#define MK_KXS 1.f
#else
#define MK_KXS (1.f / MK_KX)
#endif
struct EpiSwiGLU {
    static constexpr bool PERM = true; static constexpr bool FP8 = true;
    bf16_t* HB;
    __device__ __forceinline__ void operator()(const f32x4 (&acc)[2][2][4][2], const pg8::Unit& u, int wr, int wc, int fr, int fq) const {
        asm volatile("" : "+v"(fr), "+v"(fq));
#pragma unroll
        for (int ai = 0; ai < 2; ++ai)
#pragma unroll
            for (int m = 0; m < 4; ++m) { const size_t row = (size_t)u.pm * 256 + ai * 128 + wr * 64 + m * 16 + fr;
                float h[4];
#pragma unroll
                for (int e = 0; e < 4; ++e) { const float x = acc[ai][0][m][0][e] * (MK_KXS / WSC); h[e] = x * fsigmoid(x) * (acc[ai][0][m][1][e] * (MK_KXS / WSC)); }
                int w0 = 0; w0 = __builtin_amdgcn_cvt_pk_fp8_f32(h[0], h[1], w0, false); w0 = __builtin_amdgcn_cvt_pk_fp8_f32(h[2], h[3], w0, true);
                *(unsigned*)((unsigned char*)HB + row * 512 + u.pn * 64 + wc * 16 + 4 * fq) = (unsigned)w0; }
    }
};
struct EpiMoeDown2 {
    static constexpr bool PERM = true; static constexpr bool FP8 = true;
    bf16_t* YS; const int* slot; const float* gate; const int* cnt; int cap, pad;
    __device__ __forceinline__ void operator()(const f32x4 (&acc)[2][2][4][2], const pg8::Unit& u, int wr, int wc, int fr, int fq) const {
        asm volatile("" : "+v"(fr), "+v"(fq));
        const int n_e = cnt[u.e];
        int sl[8]; float gt[8];
#pragma unroll
        for (int q = 0; q < 8; ++q) { const int pos = 256 * u.j + (q >> 2) * 128 + wr * 64 + (q & 3) * 16 + fr; const size_t li = (size_t)u.e * cap + pos; sl[q] = slot[li]; gt[q] = gate[li]; }
#pragma unroll
        for (int q = 0; q < 8; ++q) gt[q] *= (MK_KXS * 4.f / WSC);
#pragma unroll
        for (int ai = 0; ai < 2; ++ai)
#pragma unroll
            for (int m = 0; m < 4; ++m) { const int q = ai * 4 + m; const int pos = 256 * u.j + ai * 128 + wr * 64 + m * 16 + fr;
                if (pos < n_e) { const f32x4 v0 = acc[ai][0][m][0] * gt[q], v1 = acc[ai][0][m][1] * gt[q];
                    int w0 = 0, w1 = 0; w0 = __builtin_amdgcn_cvt_pk_fp8_f32(v0.x, v0.y, w0, false); w0 = __builtin_amdgcn_cvt_pk_fp8_f32(v0.z, v0.w, w0, true);
                    w1 = __builtin_amdgcn_cvt_pk_fp8_f32(v1.x, v1.y, w1, false); w1 = __builtin_amdgcn_cvt_pk_fp8_f32(v1.z, v1.w, w1, true);
                    u32x2 w; w.x = (unsigned)w0; w.y = (unsigned)w1;
                    *(u32x2*)((unsigned char*)YS + (size_t)sl[q] * 1024 + u.pn * 128 + wc * 32 + 8 * fq) = w; } }
    }
};
__device__ __forceinline__ void phase_moe_up(const Frame& F, const bf16_t* N, const bf16_t* W13t, const MoeBufs& mb) {
    LAS int* pre = (LAS int*)(F.lds + 9 * pg8::HTB);
    const int total = moe_order_init(F, mb.cnt, pre);
    pg8::Gemm g{N, W13t, 512, (long)1024 * 512, mb.tok, mb.cnt, mb.cap};
    MoeOrder S{F.G, F.bid, total, pre, 3};
    EpiSwiGLU E{mb.HB};
    pg8::gemm_phase<true>(F.lds, g, S, E);
}
__device__ __forceinline__ void phase_moe_down(const Frame& F, const bf16_t* W2t, const MoeBufs& mb) {
    LAS int* pre = (LAS int*)(F.lds + 9 * pg8::HTB);
    const int total = moe_order_init(F, mb.cnt, pre);
    pg8::Gemm g{mb.HB, W2t, 256, (long)1024 * 256, nullptr, nullptr, 0};
    MoeOrder S{F.G, F.bid, total, pre, 3};
    EpiMoeDown2 E{mb.YS, mb.slot, mb.gate, mb.cnt, mb.cap, 0};
    pg8::gemm_phase<false>(F.lds, g, S, E);
}
template <bool FINAL> __device__ __forceinline__ void phase_combine(const Frame& F, const Args& a, int l, const HRows& H, const bf16_t* YS, bf16_t* N, float* OUT, int row0, int nrows, bool latent_only) {
    const float* mods = (const float*)(a.ws + FW_MODS) + (size_t)l * 3 * 6144;
    const float* modsn = (const float*)(a.ws + FW_MODS) + (size_t)(l + 1) * 3 * 6144;
    const float* g1n = a.in[IN_N1G] + (l + 1) * D;
    const int gw = F.bid * NWAVES + F.wave, NGW = F.G * NWAVES;
    const int nb = nrows / ROWS; const int neff = latent_only ? nb * SEQ : nrows;
    for (int i = gw; i < neff; i += NGW) {
        const int lr = latent_only ? (i / SEQ) * ROWS + CTX + (i % SEQ) : i;
        const int rg = row0 + lr, b = rg / ROWS, p = rg % ROWS; const int mr = p < CTX ? 2 : b;
        const float* gt = mods + (size_t)mr * 6144 + 5 * 1024;
        u32x2* hr = (u32x2*)H.row(rg) + F.lane;
        const unsigned* y0 = (const unsigned*)((const unsigned char*)YS + (size_t)(lr * 2) * 1024) + F.lane; const unsigned* y1 = (const unsigned*)((const unsigned char*)YS + (size_t)(lr * 2 + 1) * 1024) + F.lane;
        u32x2 hw[4]; unsigned a0[4], a1[4];
#pragma unroll
        for (int j = 0; j < 4; ++j) { hw[j] = hr[64 * j]; a0[j] = y0[64 * j]; a1[j] = y1[64 * j]; }
        f32x4 v[4]; float ss = 0.f;
#pragma unroll
        for (int j = 0; j < 4; ++j) { const int c = 4 * F.lane + 256 * j; const f32x4 g = *(const f32x4*)(gt + c) * (1.f / 4.f);
            v[j] = bf4(hw[j]) + g * (fp8x4(a0[j]) + fp8x4(a1[j]));
            if constexpr (FINAL) { *((f32x4*)(OUT + ((size_t)(b * SEQ + (p - CTX))) * D) + F.lane + 64 * j) = v[j]; }
            else { u32x2 w; w.x = cvtpk(v[j].x, v[j].y); w.y = cvtpk(v[j].z, v[j].w); hr[64 * j] = w;
                   v[j] = bf4(w);
                   ss += (v[j].x * v[j].x + v[j].y * v[j].y) + (v[j].z * v[j].z + v[j].w * v[j].w); } }
        if constexpr (!FINAL) { const float rs = rsqrtf(wave_sum(ss) * (1.f / D) + EPS); const float* m = modsn + (size_t)mr * 6144;
            u32x2* o8 = (u32x2*)(N + (size_t)lr * D) + F.lane;
#pragma unroll
            for (int j = 0; j < 4; ++j) { const int c = 4 * F.lane + 256 * j; const f32x4 gg = *(const f32x4*)(g1n + c), sh = *(const f32x4*)(m + c), sc = *(const f32x4*)(m + 1024 + c);
                const f32x4 y = v[j] * rs * gg * (sc + 1.f) + sh; u32x2 w; w.x = cvtpk(y.x, y.y); w.y = cvtpk(y.z, y.w); o8[64 * j] = w; } }
    }
}
struct GlaBufs {
    bf16_t *Qg, *Kg;
    bf16_t *Vg, *Gg;
    float* A1;
    bf16_t *QD, *KXT, *ATT;
    float* GD;
    bf16_t *OF, *OB;
    float *ES, *DS;
};
struct EpiInL1 {
    static constexpr bool PERM = true; static constexpr bool FP8 = false;
    GlaBufs gb;
    __device__ __forceinline__ void operator()(const f32x4 (&acc)[2][2][4][2], const pg8::Unit& u, int wr, int wc, int fr, int fq) const {
        asm volatile("" : "+v"(fr), "+v"(fq));
        const int pn = u.pn;
        if (pn < 12) {
            bf16_t* dst; int ld, c0; float sc = 1.f;
            if (pn < 2) { dst = gb.Qg; ld = 512; c0 = pn * 256; sc = 0.08838834764831845f; }
            else if (pn < 4) { dst = gb.Kg; ld = 512; c0 = (pn - 2) * 256; }
            else if (pn < 8) { dst = gb.Vg; ld = 1024; c0 = (pn - 4) * 256; }
            else { dst = gb.Gg; ld = 1024; c0 = (pn - 8) * 256; }
#pragma unroll
            for (int ai = 0; ai < 2; ++ai)
#pragma unroll
                for (int m = 0; m < 4; ++m) { const size_t row = (size_t)u.pm * 256 + ai * 128 + wr * 64 + m * 16 + fr;
#pragma unroll
                    for (int bj = 0; bj < 2; ++bj) { f32x4 v0 = acc[ai][bj][m][0] * sc, v1 = acc[ai][bj][m][1] * sc;
                        u32x4 w; w.x = cvtpk(v0.x, v0.y); w.y = cvtpk(v0.z, v0.w); w.z = cvtpk(v1.x, v1.y); w.w = cvtpk(v1.z, v1.w);
                        *(u32x4*)(dst + row * ld + c0 + bj * 128 + wc * 32 + 8 * fq) = w; } }
        } else if (wc == 0) {
#pragma unroll
            for (int ai = 0; ai < 2; ++ai)
#pragma unroll
                for (int m = 0; m < 4; ++m) { const size_t row = (size_t)u.pm * 256 + ai * 128 + wr * 64 + m * 16 + fr;
                    *(f32x4*)(gb.A1 + row * 32 + 8 * fq) = acc[ai][0][m][0]; *(f32x4*)(gb.A1 + row * 32 + 8 * fq + 4) = acc[ai][0][m][1]; }
        }
    }
};

namespace gla {
constexpr int NCH = ROWS / 64;
__device__ __forceinline__ int chunk_base(int dir, int c) { return dir == 0 ? 64 * c : (c < 4 ? 192 - 64 * c : 16576 - 64 * (c - 4)); }
__device__ __forceinline__ int crow(int r, int hi) { return (r & 3) + 8 * (r >> 2) + 4 * hi; }
typedef short s16x4 __attribute__((ext_vector_type(4)));

__device__ __forceinline__ void prep_phase(const Frame& F, const Args& a, const GlaBufs& gb, int nrows) {
    const int nb = nrows / ROWS, nitems = nb * 8 * NCH;
    const float* w_a2 = a.in[IN_GLAWA2]; const float* b_a2 = a.in[IN_GLABA2];
    LAS float* a1s = (LAS float*)F.lds;
    LAS float* gsum = a1s + 64 * 16;
    LAS bf16_t* qds = (LAS bf16_t*)(F.lds + 8192);
    LAS bf16_t* kxs = qds + 64 * 136;
    const int d = F.tid & 127, ig = F.tid >> 7, r32 = F.lane & 31, hi = F.lane >> 5;
    u32x4 fq[2], fk[2]; f32x4 fa = {0.f, 0.f, 0.f, 0.f};
#define PREP_FETCH(itn) do { const int c_ = (itn) % NCH; int rr_ = (itn) / NCH; const int dir_ = rr_ & 1; rr_ >>= 1; const int h_ = rr_ & 3; const int b_ = rr_ >> 2; \
        const int lb_ = b_ * ROWS, base_ = chunk_base(dir_, c_); \
        if (F.tid < 256) { const int i_ = F.tid >> 2, q4_ = F.tid & 3; const int row_ = lb_ + (dir_ ? base_ + 63 - i_ : base_ + i_); fa = *(const f32x4*)(gb.A1 + (size_t)row_ * 32 + dir_ * 16 + q4_ * 4); } \
        _Pragma("unroll") for (int u_ = 0; u_ < 2; ++u_) { const int ch_ = F.tid + 512 * u_, i_ = ch_ >> 4, cc_ = ch_ & 15; const size_t row_ = (size_t)lb_ + (dir_ ? base_ + 63 - i_ : base_ + i_); \
            fq[u_] = *(const u32x4*)(gb.Qg + row_ * 512 + h_ * 128 + cc_ * 8); fk[u_] = *(const u32x4*)(gb.Kg + row_ * 512 + h_ * 128 + cc_ * 8); } } while (0)
    if (F.bid < nitems) PREP_FETCH(F.bid);
    for (int it = F.bid; it < nitems; it += F.G) {
        const int c = it % NCH; int rr = it / NCH; const int dir = rr & 1; rr >>= 1; const int h = rr & 3; const int b = rr >> 2;
        const int lb = b * ROWS, base = chunk_base(dir, c);
        __syncthreads();
        if (F.tid < 256) { const int i = F.tid >> 2, q4 = F.tid & 3; *(LAS f32x4*)(a1s + i * 16 + q4 * 4) = fa; }
#pragma unroll
        for (int u = 0; u < 2; ++u) { const int ch = F.tid + 512 * u, i = ch >> 4, cc = ch & 15;
            *(LAS u32x4*)(qds + i * 136 + cc * 8) = fq[u]; *(LAS u32x4*)(kxs + i * 136 + cc * 8) = fk[u]; }
        if (it + F.G < nitems) PREP_FETCH(it + F.G);
        float w2[16];
#pragma unroll
        for (int r = 0; r < 16; ++r) w2[r] = w_a2[(dir * 16 + r) * 512 + h * 128 + d];
        const float bb = b_a2[dir * 512 + h * 128 + d];
        __syncthreads();
        float bl[16]; float run = 0.f;
#pragma unroll
        for (int ii = 0; ii < 16; ++ii) { const int i = ig * 16 + ii; float z = bb;
#pragma unroll
            for (int r4 = 0; r4 < 4; ++r4) { const f32x4 av = *(const LAS f32x4*)(a1s + i * 16 + 4 * r4); z += av.x * w2[4 * r4] + av.y * w2[4 * r4 + 1] + av.z * w2[4 * r4 + 2] + av.w * w2[4 * r4 + 3]; }
            const float la = (fminf(z, 0.f) - 0.6931471805599453f * __builtin_amdgcn_logf(1.f + __builtin_amdgcn_exp2f(-fabsf(z) * LOG2E))) * (1.f / 16.f); run += la; bl[ii] = run; }
        gsum[ig * 128 + d] = run;
        __syncthreads();
        float pre = 0.f, tot = 0.f;
#pragma unroll
        for (int g = 0; g < 4; ++g) { const float v = gsum[g * 128 + d]; pre += (g < ig) ? v : 0.f; tot += v; }
#pragma unroll
        for (int ii = 0; ii < 16; ++ii) { const int i = ig * 16 + ii; const float bv = bl[ii] + pre;
            const float qv = bf2f(qds[i * 136 + d]), kv = bf2f(kxs[i * 136 + d]);
            const float eb = __builtin_amdgcn_exp2f(bv * LOG2E); const float qd = qv * eb, kx = kv * __builtin_amdgcn_rcpf(eb);
            qds[i * 136 + d] = (bf16_t)(cvtpk(qd, qd) & 0xffffu); kxs[i * 136 + d] = (bf16_t)(cvtpk(kx, kx) & 0xffffu); }
        if (ig == 0) { const int dl = d & 31, r = (dl & 3) | ((dl >> 3) << 2), hh = (dl >> 2) & 1; gb.GD[(size_t)it * 128 + ((d >> 5) * 2 + hh) * 16 + r] = __builtin_amdgcn_exp2f(tot * LOG2E); }
        __syncthreads();
        bf16_t* QDi = gb.QD + (size_t)it * 8192; bf16_t* KXTi = gb.KXT + (size_t)it * 8192; bf16_t* ATTi = gb.ATT + (size_t)it * 4096;
#pragma unroll
        for (int u = 0; u < 2; ++u) { const int ch = F.tid + 512 * u;
            { const int i = ch >> 4, cb = ch & 15; *(u32x4*)(QDi + i * 128 + cb * 8) = *(const LAS u32x4*)(qds + i * 136 + cb * 8); }
            { const int d2 = ch & 127, jc = ch >> 7; unsigned short t[8];
#pragma unroll
              for (int jj = 0; jj < 8; ++jj) t[jj] = kxs[(jc * 8 + jj) * 136 + d2];
              u32x4 w = {(unsigned)t[0] | ((unsigned)t[1] << 16), (unsigned)t[2] | ((unsigned)t[3] << 16), (unsigned)t[4] | ((unsigned)t[5] << 16), (unsigned)t[6] | ((unsigned)t[7] << 16)};
              *(u32x4*)(KXTi + d2 * 64 + jc * 8) = w; } }
        if (F.wave < 4) { const int it_ = F.wave >> 1, jt = F.wave & 1;
            f32x16 acc = {};
            if (jt <= it_) {
#pragma unroll
                for (int ks = 0; ks < 8; ++ks) { const bf16x8 A = *(const LAS bf16x8*)(qds + (it_ * 32 + r32) * 136 + ks * 16 + 8 * hi); const bf16x8 B = *(const LAS bf16x8*)(kxs + (jt * 32 + r32) * 136 + ks * 16 + 8 * hi);
                    acc = __builtin_amdgcn_mfma_f32_32x32x16_bf16(A, B, acc, 0, 0, 0); } }
#pragma unroll
            for (int r = 0; r < 16; ++r) { const int i = it_ * 32 + crow(r, hi), j = jt * 32 + r32; const float v = (j <= i) ? acc[r] : 0.f; ATTi[i * 64 + j] = (bf16_t)(cvtpk(v, v) & 0xffffu); } }
    }
#undef PREP_FETCH
    __syncthreads();
}

__device__ __forceinline__ int v_st2(int k, int c) { const int kk = (k & ~0xC) | ((k & 4) << 1) | ((k & 8) >> 1); return ((kk >> 3) * 2 + (c >> 5)) * 512 + ((kk & 7) * 32 + (c & 31)) * 2; }
__device__ __forceinline__ int v_rd_base(int lane) { return ((lane & 3) << 3) | (((lane >> 2) & 3) << 6) | (((lane >> 4) & 1) << 5) | (((lane >> 5) & 1) << 8); }
constexpr int v_rd_off2(int ks, int half) { return ks * 2048 + half * 1024; }
template <int OFF> __device__ __forceinline__ s16x4 tr_read(int vb) { s16x4 r; asm volatile("ds_read_b64_tr_b16 %0, %1 offset:%2" : "=&v"(r) : "v"(vb), "i"(OFF) : "memory"); return r; }

constexpr int NGRP = 4, GCH = NCH / NGRP;
static_assert(NGRP * GCH == NCH && (GCH & 1) == 1, "scan groups");
constexpr int SC_SLOT = 49664, SC_QD = 0, SC_KX = 16384, SC_AT = 32768, SC_V = 40960, SC_GD = 49152, SC_SB = 2 * SC_SLOT, SC_OS = SC_SB + 2 * 8704 * 2;
static_assert(SC_OS + 2 * 8192 + 64 <= LDS_BYTES, "scan LDS map");

__device__ __forceinline__ int scan_id(int g, int rest, int es) { const int sidx = g * 16 + rest; return (sidx & 7) + 8 * ((sidx >> 3) * 4 + es); }
__device__ __forceinline__ void scan_unmap(int id, int& g, int& rest, int& es) { const int x = id & 7, y = id >> 3; es = y & 3; const int sidx = x + 8 * (y >> 2); g = sidx >> 4; rest = sidx & 15; }
__device__ __forceinline__ void scan_pass1(const Frame& F, const GlaBufs& gb, int nrows) {
    const int nb = nrows / ROWS, nchains = nb * 32;
    if (F.bid >= (NGRP - 1) * nchains) return;
    const int dt = F.wave >> 1, et = F.wave & 1, r32 = F.lane & 31, hi = F.lane >> 5, t = F.tid;
    LAS unsigned char* L = F.lds;
    const int wk0 = ((t >> 3) * 128) + ((((t & 7) ^ ((t >> 4) & 7))) << 4), wk1 = (((t + 512) >> 3) * 128) + (((((t + 512) & 7) ^ (((t + 512) >> 4) & 7))) << 4);
    const int wv0 = v_st2(t >> 3, (t & 7) * 8);
    const int rkx = SC_KX + (dt * 32 + r32) * 128, skx = ((dt * 32 + r32) >> 1) & 7;
    const int vrd = v_rd_base(F.lane) + et * 512;
    int g, rest, es; scan_unmap(F.bid, g, rest, es); const int dir = rest & 1, h = (rest >> 1) & 3, b = rest >> 3;
    const int lb = b * ROWS; const int item0 = ((b * 4 + h) * 2 + dir) * NCH; const int c0 = g * GCH, c1 = c0 + GCH;
    const unsigned vcol = (unsigned)(lb * 1024 + h * 256 + es * 64 + (t & 7) * 8);
    f32x16 S = {}, Dg;
#pragma unroll
    for (int r = 0; r < 16; ++r) Dg[r] = 1.f;
    u32x4 pk0[2], pk1[2], pv0[2]; f32x4 pg0[2] = {{0.f, 0.f, 0.f, 0.f}, {0.f, 0.f, 0.f, 0.f}};
#define P1_LOAD(c, Z) do { const size_t item_ = (size_t)(item0 + (c)); const int base_ = chunk_base(dir, (c)); \
        const u32x4* k_ = (const u32x4*)(gb.KXT + item_ * 8192) + t; pk0[Z] = k_[0]; pk1[Z] = k_[512]; \
        { const int j_ = t >> 3; const int row_ = dir ? base_ + 63 - j_ : base_ + j_; pv0[Z] = *(const u32x4*)(gb.Vg + (vcol + (unsigned)row_ * 1024u)); } \
        pg0[Z] = ((const f32x4*)(gb.GD + item_ * 128))[t & 31]; } while (0)
#define P1_STEP(c, PAR) do { LAS unsigned char* s_ = L + (PAR) * SC_SLOT; \
        *(LAS u32x4*)(s_ + SC_KX + wk0) = pk0[PAR]; *(LAS u32x4*)(s_ + SC_KX + wk1) = pk1[PAR]; *(LAS u32x4*)(s_ + SC_V + wv0) = pv0[PAR]; if (t < 32) *(LAS f32x4*)(s_ + SC_GD + t * 16) = pg0[PAR]; \
        __syncthreads(); \
        if ((c) + 2 < c1) P1_LOAD((c) + 2, PAR); \
        bf16x8 vb_[4]; \
        { const int vr_ = (int)(uintptr_t)(s_ + SC_V) + vrd; \
          const s16x4 l0 = tr_read<v_rd_off2(0, 0)>(vr_), h0 = tr_read<v_rd_off2(0, 1)>(vr_), l1 = tr_read<v_rd_off2(1, 0)>(vr_), h1 = tr_read<v_rd_off2(1, 1)>(vr_); \
          const s16x4 l2 = tr_read<v_rd_off2(2, 0)>(vr_), h2 = tr_read<v_rd_off2(2, 1)>(vr_), l3 = tr_read<v_rd_off2(3, 0)>(vr_), h3 = tr_read<v_rd_off2(3, 1)>(vr_); \
          asm volatile("s_waitcnt lgkmcnt(0)" ::: "memory"); __builtin_amdgcn_sched_barrier(0); \
          vb_[0] = (bf16x8){l0[0], l0[1], l0[2], l0[3], h0[0], h0[1], h0[2], h0[3]}; vb_[1] = (bf16x8){l1[0], l1[1], l1[2], l1[3], h1[0], h1[1], h1[2], h1[3]}; \
          vb_[2] = (bf16x8){l2[0], l2[1], l2[2], l2[3], h2[0], h2[1], h2[2], h2[3]}; vb_[3] = (bf16x8){l3[0], l3[1], l3[2], l3[3], h3[0], h3[1], h3[2], h3[3]}; } \
        _Pragma("unroll") for (int ks = 0; ks < 4; ++ks) { const bf16x8 kf_ = *(const LAS bf16x8*)(s_ + rkx + (((2 * ks + hi) ^ skx) << 4)); S = __builtin_amdgcn_mfma_f32_32x32x16_bf16(kf_, vb_[ks], S, 0, 0, 0); } \
        { const LAS f32x4* gp_ = (const LAS f32x4*)(s_ + SC_GD + (dt * 2 + hi) * 64); \
          _Pragma("unroll") for (int q = 0; q < 4; ++q) { const f32x4 g_ = gp_[q]; S[4 * q] *= g_.x; S[4 * q + 1] *= g_.y; S[4 * q + 2] *= g_.z; S[4 * q + 3] *= g_.w; \
              Dg[4 * q] *= g_.x; Dg[4 * q + 1] *= g_.y; Dg[4 * q + 2] *= g_.z; Dg[4 * q + 3] *= g_.w; } } \
    } while (0)
    P1_LOAD(c0, 0); P1_LOAD(c0 + 1, 1);
    for (int i = 0; i + 1 < GCH; i += 2) { P1_STEP(c0 + i, 0); P1_STEP(c0 + i + 1, 1); }
    P1_STEP(c1 - 1, 0);
#undef P1_LOAD
#undef P1_STEP
    f32x4* Eo = (f32x4*)(gb.ES + ((size_t)F.bid * NTHR + t) * 16); f32x4* Do = (f32x4*)(gb.DS + ((size_t)F.bid * NTHR + t) * 16);
#pragma unroll
    for (int q = 0; q < 4; ++q) { Eo[q] = (f32x4){S[4 * q], S[4 * q + 1], S[4 * q + 2], S[4 * q + 3]}; Do[q] = (f32x4){Dg[4 * q], Dg[4 * q + 1], Dg[4 * q + 2], Dg[4 * q + 3]}; }
    __syncthreads();
}

__device__ __forceinline__ void scan_pass2(const Frame& F, const GlaBufs& gb, int nrows) {
    const int nb = nrows / ROWS, nchains = nb * 32;
    if (F.bid >= NGRP * nchains) return;
    const int dt = F.wave >> 1, et = F.wave & 1, r32 = F.lane & 31, hi = F.lane >> 5, t = F.tid;
    constexpr int SLOT = SC_SLOT, O_QD = SC_QD, O_KX = SC_KX, O_AT = SC_AT, O_V = SC_V, O_GD = SC_GD, O_SB = SC_SB, O_OS = SC_OS;
    LAS unsigned char* L = F.lds;
    const int wq0 = ((t >> 4) * 256) + ((((t & 15) ^ ((t >> 4) & 15))) << 4), wq1 = (((t + 512) >> 4) * 256) + (((((t + 512) & 15) ^ (((t + 512) >> 4) & 15))) << 4);
    const int wk0 = ((t >> 3) * 128) + ((((t & 7) ^ ((t >> 4) & 7))) << 4), wk1 = (((t + 512) >> 3) * 128) + (((((t + 512) & 7) ^ (((t + 512) >> 4) & 7))) << 4);
    const int wa0 = wk0, wv0 = v_st2(t >> 3, (t & 7) * 8);
    const int rkx = O_KX + (dt * 32 + r32) * 128, skx = ((dt * 32 + r32) >> 1) & 7;
    const int rqd = O_QD + ((dt & 1) * 32 + r32) * 256, sqd = r32 & 15;
    const int rat = O_AT + ((dt & 1) * 32 + r32) * 128, sat = (((dt & 1) * 32 + r32) >> 1) & 7;
    const int vrd = v_rd_base(F.lane) + et * 512;
    {
        int g, rest, es; scan_unmap(F.bid, g, rest, es); const int dir = rest & 1, h = (rest >> 1) & 3, b = rest >> 3;
        const int lb = b * ROWS; const int item0 = ((b * 4 + h) * 2 + dir) * NCH; const int c0 = g * GCH, c1 = c0 + GCH;
        bf16_t* const Obase = dir ? gb.OB : gb.OF;
        const unsigned ocol = (unsigned)(lb * 1024 + h * 256 + es * 64 + (t & 7) * 8);
        const unsigned vcol = (unsigned)(lb * 1024 + h * 256 + es * 64 + (t & 7) * 8);
        f32x16 S = {};
        u32x4 pq0[2], pq1[2], pk0[2], pk1[2], pa0[2], pv0[2]; f32x4 pg0[2] = {{0.f, 0.f, 0.f, 0.f}, {0.f, 0.f, 0.f, 0.f}};
#define GLA_LOAD(c, Z) do { const size_t item_ = (size_t)(item0 + (c)); const int base_ = chunk_base(dir, (c)); \
            const u32x4* q_ = (const u32x4*)(gb.QD + item_ * 8192) + t; pq0[Z] = q_[0]; pq1[Z] = q_[512]; \
            const u32x4* k_ = (const u32x4*)(gb.KXT + item_ * 8192) + t; pk0[Z] = k_[0]; pk1[Z] = k_[512]; \
            pa0[Z] = ((const u32x4*)(gb.ATT + item_ * 4096))[t]; \
            { const int j_ = t >> 3; const int row_ = dir ? base_ + 63 - j_ : base_ + j_; pv0[Z] = *(const u32x4*)(gb.Vg + (vcol + (unsigned)row_ * 1024u)); } \
            pg0[Z] = ((const f32x4*)(gb.GD + item_ * 128))[t & 31]; } while (0)
#define GLA_STAGE(PAR) do { LAS unsigned char* s_ = L + (PAR) * SLOT; \
            *(LAS u32x4*)(s_ + O_QD + wq0) = pq0[PAR]; *(LAS u32x4*)(s_ + O_QD + wq1) = pq1[PAR]; *(LAS u32x4*)(s_ + O_KX + wk0) = pk0[PAR]; *(LAS u32x4*)(s_ + O_KX + wk1) = pk1[PAR]; \
            *(LAS u32x4*)(s_ + O_AT + wa0) = pa0[PAR]; *(LAS u32x4*)(s_ + O_V + wv0) = pv0[PAR]; if (t < 32) *(LAS f32x4*)(s_ + O_GD + t * 16) = pg0[PAR]; } while (0)
#define GLA_STEP(c, PAR) do { \
            GLA_STAGE(PAR); \
            __syncthreads(); \
            if ((c) + 2 < c1) GLA_LOAD((c) + 2, PAR); \
            if ((c) > c0) { const int i_ = t >> 3; const int pb_ = chunk_base(dir, (c) - 1); const int rw_ = dir ? pb_ + 63 - i_ : pb_ + i_; \
                *(u32x4*)(Obase + (ocol + (unsigned)rw_ * 1024u)) = *(const LAS u32x4*)(L + O_OS + (1 - (PAR)) * 8192 + t * 16); } \
            const LAS unsigned char* s_ = L + (PAR) * SLOT; \
            bf16x8 vb_[4]; \
            { const int vr_ = (int)(uintptr_t)(s_ + O_V) + vrd; \
              const s16x4 l0 = tr_read<v_rd_off2(0, 0)>(vr_), h0 = tr_read<v_rd_off2(0, 1)>(vr_), l1 = tr_read<v_rd_off2(1, 0)>(vr_), h1 = tr_read<v_rd_off2(1, 1)>(vr_); \
              const s16x4 l2 = tr_read<v_rd_off2(2, 0)>(vr_), h2 = tr_read<v_rd_off2(2, 1)>(vr_), l3 = tr_read<v_rd_off2(3, 0)>(vr_), h3 = tr_read<v_rd_off2(3, 1)>(vr_); \
              asm volatile("s_waitcnt lgkmcnt(0)" ::: "memory"); __builtin_amdgcn_sched_barrier(0); \
              vb_[0] = (bf16x8){l0[0], l0[1], l0[2], l0[3], h0[0], h0[1], h0[2], h0[3]}; vb_[1] = (bf16x8){l1[0], l1[1], l1[2], l1[3], h1[0], h1[1], h1[2], h1[3]}; \
              vb_[2] = (bf16x8){l2[0], l2[1], l2[2], l2[3], h2[0], h2[1], h2[2], h2[3]}; vb_[3] = (bf16x8){l3[0], l3[1], l3[2], l3[3], h3[0], h3[1], h3[2], h3[3]}; } \
            _Pragma("unroll") for (int ks = 0; ks < 4; ++ks) { const bf16x8 kf_ = *(const LAS bf16x8*)(s_ + rkx + (((2 * ks + hi) ^ skx) << 4)); S = __builtin_amdgcn_mfma_f32_32x32x16_bf16(kf_, vb_[ks], S, 0, 0, 0); } \
            if (dt < 2) { f32x16 o_ = {}; const LAS bf16_t* sp_ = (const LAS bf16_t*)(L + O_SB) + (PAR) * 8704 + (et * 32 + r32) * 136 + 8 * hi; \
                _Pragma("unroll") for (int ks = 0; ks < 8; ++ks) { const bf16x8 qf_ = *(const LAS bf16x8*)(s_ + rqd + (((2 * ks + hi) ^ sqd) << 4)); const bf16x8 sf_ = *(const LAS bf16x8*)(sp_ + 16 * ks); \
                    o_ = __builtin_amdgcn_mfma_f32_32x32x16_bf16(qf_, sf_, o_, 0, 0, 0); } \
                _Pragma("unroll") for (int ks = 0; ks < 4; ++ks) { const bf16x8 af_ = *(const LAS bf16x8*)(s_ + rat + (((2 * ks + hi) ^ sat) << 4)); o_ = __builtin_amdgcn_mfma_f32_32x32x16_bf16(af_, vb_[ks], o_, 0, 0, 0); } \
                LAS bf16_t* os_ = (LAS bf16_t*)(L + O_OS + (PAR) * 8192) + et * 32 + r32; \
                _Pragma("unroll") for (int r = 0; r < 16; ++r) os_[(dt * 32 + crow(r, hi)) * 64] = (bf16_t)(cvtpk(o_[r], o_[r]) & 0xffffu); } \
            { const LAS f32x4* gp_ = (const LAS f32x4*)(s_ + O_GD + (dt * 2 + hi) * 64); \
              _Pragma("unroll") for (int q = 0; q < 4; ++q) { const f32x4 g_ = gp_[q]; S[4 * q] *= g_.x; S[4 * q + 1] *= g_.y; S[4 * q + 2] *= g_.z; S[4 * q + 3] *= g_.w; } } \
            { LAS bf16_t* sw_ = (LAS bf16_t*)(L + O_SB) + (1 - (PAR)) * 8704 + (et * 32 + r32) * 136 + dt * 32 + 4 * hi; \
              _Pragma("unroll") for (int gq = 0; gq < 4; ++gq) { u32x2 w_; w_.x = cvtpk(S[4 * gq], S[4 * gq + 1]); w_.y = cvtpk(S[4 * gq + 2], S[4 * gq + 3]); *(LAS u32x2*)(sw_ + 8 * gq) = w_; } } \
        } while (0)
        GLA_LOAD(c0, 0); GLA_LOAD(c0 + 1, 1);
        if (g > 0) {
            { const f32x4* Ei = (const f32x4*)(gb.ES + ((size_t)scan_id(0, rest, es) * NTHR + t) * 16);
#pragma unroll
              for (int q = 0; q < 4; ++q) { const f32x4 e_ = Ei[q]; S[4 * q] = e_.x; S[4 * q + 1] = e_.y; S[4 * q + 2] = e_.z; S[4 * q + 3] = e_.w; } }
            for (int j = 1; j < g; ++j) { const size_t sid_ = (size_t)scan_id(j, rest, es); const f32x4* Ei = (const f32x4*)(gb.ES + (sid_ * NTHR + t) * 16); const f32x4* Di = (const f32x4*)(gb.DS + (sid_ * NTHR + t) * 16);
#pragma unroll
              for (int q = 0; q < 4; ++q) { const f32x4 e_ = Ei[q], d_ = Di[q]; S[4 * q] = S[4 * q] * d_.x + e_.x; S[4 * q + 1] = S[4 * q + 1] * d_.y + e_.y; S[4 * q + 2] = S[4 * q + 2] * d_.z + e_.z; S[4 * q + 3] = S[4 * q + 3] * d_.w + e_.w; } }
        }
        { LAS bf16_t* sw_ = (LAS bf16_t*)(L + O_SB) + (et * 32 + r32) * 136 + dt * 32 + 4 * hi;
#pragma unroll
          for (int gq = 0; gq < 4; ++gq) { u32x2 w_; w_.x = cvtpk(S[4 * gq], S[4 * gq + 1]); w_.y = cvtpk(S[4 * gq + 2], S[4 * gq + 3]); *(LAS u32x2*)(sw_ + 8 * gq) = w_; } }
        for (int i = 0; i + 1 < GCH; i += 2) { GLA_STEP(c0 + i, 0); GLA_STEP(c0 + i + 1, 1); }
        GLA_STEP(c1 - 1, 0);
        __syncthreads();
        { const int i_ = t >> 3; const int pb_ = chunk_base(dir, c1 - 1); const int rw_ = dir ? pb_ + 63 - i_ : pb_ + i_;
          *(u32x4*)(Obase + (ocol + (unsigned)rw_ * 1024u)) = *(const LAS u32x4*)(L + O_OS + t * 16); }
        __syncthreads();
#undef GLA_LOAD
#undef GLA_STAGE
#undef GLA_STEP
    }
}

__device__ __forceinline__ void out_phase(const Frame& F, const Args& a, const GlaBufs& gb, bf16_t* OG, int nrows) {
    const int gw = F.bid * NWAVES + F.wave, NGW = F.G * NWAVES; const int nb = nrows / ROWS;
    const f32x4 ng0 = *(const f32x4*)(a.in[IN_GLANG] + 8 * (F.lane & 31)), ng1 = *(const f32x4*)(a.in[IN_GLANG] + 8 * (F.lane & 31) + 4);
    for (int i = gw; i < nb * SEQ; i += NGW) { const size_t lr = (size_t)(i / SEQ) * ROWS + CTX + (i % SEQ);
        const u32x4* pf = (const u32x4*)(gb.OF + lr * 1024) + F.lane; const u32x4* pb = (const u32x4*)(gb.OB + lr * 1024) + F.lane; const u32x4* pg = (const u32x4*)(gb.Gg + lr * 1024) + F.lane;
        u32x4* po = (u32x4*)(OG + lr * 1024) + F.lane;
        u32x4 af[2], ab[2], ag[2];
#pragma unroll
        for (int j = 0; j < 2; ++j) { af[j] = pf[64 * j]; ab[j] = pb[64 * j]; ag[j] = pg[64 * j]; }
#pragma unroll
        for (int j = 0; j < 2; ++j) { float o[8], g[8]; float ss = 0.f;
#pragma unroll
            for (int e = 0; e < 4; ++e) { o[2 * e] = __uint_as_float(af[j][e] << 16) + __uint_as_float(ab[j][e] << 16); o[2 * e + 1] = __uint_as_float(af[j][e] & 0xffff0000u) + __uint_as_float(ab[j][e] & 0xffff0000u);
                g[2 * e] = __uint_as_float(ag[j][e] << 16); g[2 * e + 1] = __uint_as_float(ag[j][e] & 0xffff0000u); ss += o[2 * e] * o[2 * e] + o[2 * e + 1] * o[2 * e + 1]; }
            ss = half_sum32(ss);
            const float rs = rsqrtf(ss * (1.f / 256.f) + EPS);
            const float n[8] = {ng0.x, ng0.y, ng0.z, ng0.w, ng1.x, ng1.y, ng1.z, ng1.w}; float y[8];
#pragma unroll
            for (int e = 0; e < 8; ++e) y[e] = o[e] * rs * n[e] * fsilu(g[e]);
            u32x4 w; w.x = cvtpk(y[0], y[1]); w.y = cvtpk(y[2], y[3]); w.z = cvtpk(y[4], y[5]); w.w = cvtpk(y[6], y[7]); po[64 * j] = w; }
    }
}
}

struct LatentOrder {
    pg8::StaticOrder so;
    __device__ void init(int nb, int N, int G, int c) { so.init(nb * 64 * 256, N, G, c); }
    __device__ bool next(int i, pg8::Unit& u) const { if (!so.next(i, u)) return false; u.pm = (u.pm >> 6) * 65 + 1 + (u.pm & 63); return true; }
};
#define XB_TMO      128
#define XB_XCNT(j)  (256  + 64 * (j))
#define XB_XSUB(j)  (1280 + 64 * (j))
#define XB_XGEN(j)  (2304 + 64 * (j))
#define XB_TOP      3328
#define XB_TOPGEN   3392
#define XCD_BAR_WORDS 3456
#define XB_SPIN_CAP (1u << 18)

__device__ __forceinline__ unsigned xb_ld(unsigned* p)              { return __hip_atomic_load(p, __ATOMIC_RELAXED, __HIP_MEMORY_SCOPE_AGENT); }
__device__ __forceinline__ unsigned xb_add(unsigned* p, unsigned v) { return __hip_atomic_fetch_add(p, v, __ATOMIC_RELAXED, __HIP_MEMORY_SCOPE_AGENT); }
__device__ __forceinline__ unsigned xb_xcc_id() { return (unsigned)__builtin_amdgcn_s_getreg((3 << 11) | 20) & 0xFu; }
#define XB_SPIN(cond, bar) do { unsigned _sp = 0; while (cond) { __builtin_amdgcn_s_sleep(1); \
    if ((++_sp & 255u) == 0u) { if (xb_ld(&(bar)[XB_TMO])) break; if (_sp > XB_SPIN_CAP) { atomicAdd(&(bar)[XB_TMO], 1u); break; } } } } while (0)

struct XcdBarrier {
    unsigned* bar; unsigned x;
    volatile LAS unsigned* st;
};

__device__ __forceinline__ XcdBarrier xcd_barrier_post(unsigned* bar, volatile LAS unsigned* st) {
    XcdBarrier b; b.bar = bar; b.x = xb_xcc_id(); b.st = st;
    if (threadIdx.x == 0) (void)xb_add(&bar[XB_XCNT(b.x)], 1u);
    return b;
}
__device__ __forceinline__ void xcd_barrier_complete(unsigned* bar, unsigned x, unsigned& nloc, unsigned& nx) {
    const unsigned G = gridDim.x * gridDim.y * gridDim.z;
    unsigned sum, cnt, mine, sp = 0u;
    for (;;) {
        sum = 0u; cnt = 0u; mine = 0u;
#pragma unroll
        for (unsigned j = 0; j < 16; ++j) { const unsigned c = xb_ld(&bar[XB_XCNT(j)]); sum += c; cnt += (c > 0u) ? 1u : 0u; mine = (j == x) ? c : mine; }
        if (sum == G) break;
        __builtin_amdgcn_s_sleep(1);
        if ((++sp & 255u) == 0u) { if (xb_ld(&bar[XB_TMO])) break; if (sp > XB_SPIN_CAP) { atomicAdd(&bar[XB_TMO], 1u); break; } }
    }
    nloc = mine > 0u ? mine : 1u; nx = cnt > 0u ? cnt : 1u;
}

__device__ __forceinline__ void xcd_barrier(const XcdBarrier& b) {
    asm volatile("s_waitcnt vmcnt(0)" ::: "memory");
    __syncthreads();
    if (threadIdx.x == 0) {
        unsigned* bar = b.bar;
        __builtin_amdgcn_s_waitcnt(0);
        unsigned nloc = b.st[0], nx = b.st[1];
        if (nloc == 0u) { xcd_barrier_complete(bar, b.x, nloc, nx); b.st[0] = nloc; b.st[1] = nx; }
        const unsigned old = xb_add(&bar[XB_XSUB(b.x)], 1u);
        const unsigned gen = old / nloc;
        if (old + 1u == (gen + 1u) * nloc) {
            __builtin_amdgcn_fence(__ATOMIC_RELEASE, "agent");
            asm volatile("s_waitcnt vmcnt(0)" ::: "memory");
            const unsigned og = xb_add(&bar[XB_TOP], 1u);
            const unsigned tg = og / nx;
            if (og + 1u == (tg + 1u) * nx) xb_add(&bar[XB_TOPGEN], 1u);
            else XB_SPIN(xb_ld(&bar[XB_TOPGEN]) == tg, bar);
            __builtin_amdgcn_fence(__ATOMIC_ACQUIRE, "agent");
            xb_add(&bar[XB_XGEN(b.x)], 1u);
            asm volatile("s_waitcnt vmcnt(0)" ::: "memory");
        } else {
            XB_SPIN(xb_ld(&bar[XB_XGEN(b.x)]) == gen, bar);
            __builtin_amdgcn_fence(__ATOMIC_ACQUIRE, "agent");
            asm volatile("s_waitcnt vmcnt(0)" ::: "memory");
        }
    }
    __syncthreads();
}


#ifndef MK_REPEAT
#define MK_REPEAT -1
#endif
#define REPS(k) ((MK_REPEAT) == (k) ? 2 : 1)
#ifndef MK_PER_PHASE
#define MK_PER_PHASE 0
#endif
struct Bufs {
    bf16_t *N, *HH, *Q, *K, *V, *MIX; bf16_t *Hl, *Hc, *H3; float* OUT; MoeBufs mb0, mb1; bf16_t *W13t, *W2t; GlaBufs gb; bf16_t *OG, *N2b;
};
__global__ void __launch_bounds__(NTHR, 2) mk_fwd(Args a, Bufs d) {
    extern __shared__ __attribute__((aligned(16))) unsigned char lds_raw[];
    Frame F; F.lds = (LAS unsigned char*)lds_raw; F.tid = threadIdx.x; F.lane = F.tid & 63; F.wave = __builtin_amdgcn_readfirstlane(F.tid >> 6); F.G = gridDim.x; F.bid = blockIdx.x;
#define IN(k) (a.ph_lo <= (k) && (k) < a.ph_hi)
#if MK_PER_PHASE
#define SEAM(k) do { } while (0)
#else
    cg::grid_group grid = cg::this_grid();
    volatile LAS unsigned* xst = (volatile LAS unsigned*)(F.lds + LDS_BYTES - 64);
    if (F.tid < 2) xst[F.tid] = 0u;
    __syncthreads();
    unsigned* const xbw = (unsigned*)(a.ws + FW_CTL + 4096);
    if (F.bid == F.G - 1) for (int i = F.tid; i < XCD_BAR_WORDS; i += NTHR) xbw[i] = 0u;
    XcdBarrier xbar; xbar.bar = xbw; xbar.x = 0u; xbar.st = xst;
#define SEAM(k) do { if (IN(k) && IN((k) + 1)) { if ((k) == P_PRO_A) { grid.sync(); xbar = xcd_barrier_post(xbw, xst); } else xcd_barrier(xbar); } } while (0)
#endif
    const HRows H{d.Hl, d.Hc};
    const HRows H3{d.H3, d.Hc};
    constexpr int WMOE_A = WMOE_ITEMS / 12, WMOE_B = WMOE_A + (WMOE_ITEMS * 39) / 100;
    constexpr int WSPLIT = (WMOE_ITEMS * 28) / 100, WSPLIT1 = WSPLIT + (WMOE_ITEMS * 16) / 100;
    if (IN(P_PRO_A)) for (int rep_ = 0; rep_ < REPS(P_PRO_A); ++rep_) { if (rep_) xcd_barrier(xbar); { for (int q_ = 0; q_ < ((MK_REPEAT) == 100 ? 2 : 1); ++q_) { phase_pro_a(F, a); __syncthreads(); } for (int q_ = 0; q_ < ((MK_REPEAT) == 101 ? 2 : 1); ++q_) { phase_wmoe(F, a, 0, d.W13t, d.W2t, 0, 0, 0, WMOE_A); __syncthreads(); } } }
    SEAM(P_PRO_A);
    if (IN(P_PRO_B)) for (int rep_ = 0; rep_ < REPS(P_PRO_B); ++rep_) { if (rep_) xcd_barrier(xbar); phase_pro_b(F, a, d.N); }
    SEAM(P_PRO_B);
    if (IN(P_INL0)) for (int rep_ = 0; rep_ < REPS(P_INL0); ++rep_) { if (rep_) xcd_barrier(xbar); {
        pg8::Gemm g{d.N, (const bf16_t*)(a.ws + FW_WIN0), 1024, 0, nullptr, nullptr, 0};
        pg8::StaticOrder S; S.init(RTOT, 2560, F.G, F.bid);
        EpiInL0 E{d.HH, d.Q, d.K, d.V, a.in[IN_QNG], a.in[IN_KNG], (const float2*)(a.ws + FW_ROPE), 0};
        pg8::gemm_phase<false>(F.lds, g, S, E);
        { const int nun = (RTOT / 256) * 10, extra = nun - (nun / F.G) * F.G; __syncthreads(); if (F.bid >= extra) phase_wmoe(F, a, 0, d.W13t, d.W2t, extra, F.G - extra, WMOE_A, WMOE_B); }
    } }
    SEAM(P_INL0);
    if (IN(P_ATT)) for (int rep_ = 0; rep_ < REPS(P_ATT); ++rep_) { if (rep_) xcd_barrier(xbar); { conv_phase(F, a, d.HH, d.MIX, 0, RTOT); attn_phase(F, a, (const unsigned char*)d.Q, (const unsigned char*)d.K, (const unsigned char*)d.V, d.MIX, RTOT); } }
    SEAM(P_ATT);
    if (IN(P_OUTL0)) for (int rep_ = 0; rep_ < REPS(P_OUTL0); ++rep_) { if (rep_) xcd_barrier(xbar); {
        pg8::Gemm g{d.MIX, (const bf16_t*)(a.ws + FW_WOUT0), 1024, 0, nullptr, nullptr, 0};
        pg8::StaticOrder S; S.init(RTOT, 1024, F.G, F.bid);
        EpiResid2<float> E{a.in[IN_X], a.in[IN_CTX], d.Hl, d.Hc, (const float*)(a.ws + FW_MODS), 2, 0};
        pg8::gemm_phase<false>(F.lds, g, S, E);
        { const int nun = (RTOT / 256) * 4, extra = nun - (nun / F.G) * F.G; __syncthreads(); if (F.bid >= extra) phase_wmoe(F, a, 0, d.W13t, d.W2t, extra, F.G - extra, WMOE_B, WMOE_ITEMS); }
    } }
    SEAM(P_OUTL0);
    if (IN(P_ROUTE0)) { int* cntW = (int*)(a.ws + FW_CTL + 65536); phase_route(F, a, 0, H, d.N, d.mb0, 0, RTOT, false, cntW); xcd_barrier(xbar); phase_route_scatter(F, d.mb0, cntW); }
    SEAM(P_ROUTE0);
    if (IN(P_UP0)) for (int rep_ = 0; rep_ < REPS(P_UP0); ++rep_) { if (rep_) xcd_barrier(xbar); phase_moe_up(F, d.N, d.W13t, d.mb0); }
    SEAM(P_UP0);
    if (IN(P_DOWN0)) for (int rep_ = 0; rep_ < REPS(P_DOWN0); ++rep_) { if (rep_) xcd_barrier(xbar); phase_moe_down(F, d.W2t, d.mb0); }
    SEAM(P_DOWN0);
    if (IN(P_COMB0)) phase_combine<false>(F, a, 0, H, d.mb0.YS, d.N, nullptr, 0, RTOT, false);
    SEAM(P_COMB0);
    if (IN(P_INL1)) for (int rep_ = 0; rep_ < REPS(P_INL1); ++rep_) { if (rep_) xcd_barrier(xbar); {
        pg8::Gemm g{d.N, (const bf16_t*)(a.ws + FW_WIN1), 1024, 0, nullptr, nullptr, 0};
        pg8::StaticOrder S; S.init(RTOT, 3328, F.G, F.bid);
        EpiInL1 E{d.gb};
        pg8::gemm_phase<false>(F.lds, g, S, E);
        { const int nun = (RTOT / 256) * 13, extra = nun - (nun / F.G) * F.G; __syncthreads(); if (F.bid >= extra) phase_wmoe(F, a, 1, d.W13t, d.W2t, extra, F.G - extra, WSPLIT, WSPLIT1); }
    } }
    SEAM(P_INL1);
    if (IN(P_GPREP)) for (int rep_ = 0; rep_ < REPS(P_GPREP); ++rep_) { if (rep_) xcd_barrier(xbar); gla::prep_phase(F, a, d.gb, RTOT); }
    SEAM(P_GPREP);
    if (IN(P_GSCAN)) {
        if (F.bid >= 192) phase_wmoe(F, a, 1, d.W13t, d.W2t, 192, F.G - 192, 0, WSPLIT); else gla::scan_pass1(F, d.gb, RTOT);
        xcd_barrier(xbar);
        gla::scan_pass2(F, d.gb, RTOT);
        phase_wmoe(F, a, 1, d.W13t, d.W2t, 0, 0, WSPLIT1, WMOE_ITEMS);
    }
    SEAM(P_GSCAN);
    if (IN(P_GOUT)) for (int rep_ = 0; rep_ < REPS(P_GOUT); ++rep_) { if (rep_) xcd_barrier(xbar); gla::out_phase(F, a, d.gb, d.OG, RTOT); }
    SEAM(P_GOUT);
    if (IN(P_OUTL1)) {
        pg8::Gemm g{d.OG, (const bf16_t*)(a.ws + FW_WOUT1), 1024, 0, nullptr, nullptr, 0};
        LatentOrder S; S.init(2, 1024, F.G, F.bid);
        EpiResid2<bf16_t> E{d.Hl, d.Hc, d.H3, d.Hc, (const float*)(a.ws + FW_MODS) + 3 * 6144, 2, 0};
        pg8::gemm_phase<false>(F.lds, g, S, E);
    }
    SEAM(P_OUTL1);
    if (IN(P_ROUTE1)) { int* cntW = (int*)(a.ws + FW_CTL + 65536); phase_route(F, a, 1, H3, d.N2b, d.mb1, 0, RTOT, true, cntW); xcd_barrier(xbar); phase_route_scatter(F, d.mb1, cntW); }
    SEAM(P_ROUTE1);
    if (IN(P_UP1)) for (int rep_ = 0; rep_ < REPS(P_UP1); ++rep_) { if (rep_) xcd_barrier(xbar); phase_moe_up(F, d.N2b, d.W13t, d.mb1); }
    SEAM(P_UP1);
    if (IN(P_DOWN1)) for (int rep_ = 0; rep_ < REPS(P_DOWN1); ++rep_) { if (rep_) xcd_barrier(xbar); phase_moe_down(F, d.W2t, d.mb1); }
    SEAM(P_DOWN1);
    if (IN(P_COMB1)) phase_combine<true>(F, a, 1, H3, d.mb1.YS, nullptr, d.OUT, 0, RTOT, true);
#undef IN
#undef SEAM
}
__global__ void k_nan(float* out, size_t n) { size_t i = (size_t)blockIdx.x * 256 + threadIdx.x; if (i < n) out[i] = __builtin_nanf(""); }
}

extern "C" void kernel_launch(void* const* d_in, const int* in_sizes, int n_in, void* d_out, int out_size, void* d_ws, size_t ws_size, hipStream_t stream) {
  float* out = (float*)d_out; unsigned char* ws = (unsigned char*)d_ws;
  static int grid = 0;
  if (grid == 0) {
    int dev = 0, cus = 0, per_cu = 0; (void)hipGetDevice(&dev); (void)hipDeviceGetAttribute(&cus, hipDeviceAttributeMultiprocessorCount, dev);
    (void)hipFuncSetAttribute((const void*)mk_fwd, hipFuncAttributeMaxDynamicSharedMemorySize, LDS_BYTES);
    (void)hipOccupancyMaxActiveBlocksPerMultiprocessor(&per_cu, (const void*)mk_fwd, NTHR, LDS_BYTES);
    if (per_cu < 1) { fprintf(stderr, "kernel_launch: occupancy query says %d blocks per CU\n", per_cu); per_cu = 1; }
    grid = (cus > 0 ? cus : 256);
    (void)hipGetLastError();
  }
  if (FW_END > ws_size || n_in != 33 || out_size != 2 * SEQ * D) { fprintf(stderr, "kernel_launch: ws too small (%zu needed, %zu given) or n_in %d\n", (size_t)FW_END, ws_size, n_in);
    hipLaunchKernelGGL(k_nan, dim3((out_size + 255) / 256), dim3(256), 0, stream, out, (size_t)out_size); return; }
  Args a{}; for (int i = 0; i < 33; ++i) a.in[i] = (const float*)d_in[i];
  a.out = out; a.ws = ws; a.row0 = 0; a.nrows = RTOT;
  Bufs b{};
  constexpr size_t R1 = (size_t)RTOT * 1024 * 2, Rh = (size_t)RTOT * 512 * 2;
  b.N = (bf16_t*)(ws + FW_RA); b.HH = (bf16_t*)(ws + FW_RB); b.Q = (bf16_t*)(ws + FW_RB + Rh); b.K = (bf16_t*)(ws + FW_RB + 2 * Rh); b.V = (bf16_t*)(ws + FW_RB + 3 * Rh);
  b.MIX = (bf16_t*)(ws + FW_RC); b.Hl = (bf16_t*)out; b.Hc = (bf16_t*)(ws + FW_HC); b.H3 = (bf16_t*)(ws + FW_RF); b.OUT = out;
  b.mb0.cnt = (int*)(ws + FW_CTL); b.mb0.tok = (int*)(ws + FW_RD); b.mb0.slot = (int*)(ws + FW_RD) + 32 * RTOT; b.mb0.gate = (float*)(ws + FW_RC + 124 * MiB);
  b.mb0.HB = (bf16_t*)(ws + FW_RB); b.mb0.YS = (bf16_t*)(ws + FW_RC); b.mb0.cap = RTOT; b.mb0.pad = 0;
  b.mb1 = b.mb0; b.mb1.cnt = (int*)(ws + FW_CTL) + 64;
  b.W13t = (bf16_t*)(ws + FW_W13); b.W2t = (bf16_t*)(ws + FW_W2);
  b.gb.Qg = (bf16_t*)(ws + FW_RB); b.gb.Kg = (bf16_t*)(ws + FW_RB + Rh); b.gb.Vg = (bf16_t*)(ws + FW_RB + 2 * Rh);
  b.gb.Gg = (bf16_t*)(ws + FW_RC); b.gb.A1 = (float*)(ws + FW_RC + R1);
  b.gb.QD = (bf16_t*)(ws + FW_RA); b.gb.KXT = (bf16_t*)(ws + FW_RE); b.gb.ATT = (bf16_t*)(ws + FW_RC + 70 * MiB); b.gb.GD = (float*)(ws + FW_RC + 104 * MiB);
  b.gb.OF = (bf16_t*)(ws + FW_RB); b.gb.OB = (bf16_t*)(ws + FW_RF);
  b.gb.ES = (float*)(ws + FW_RC + 108 * MiB); b.gb.DS = (float*)(ws + FW_RC + 116 * MiB);
  b.OG = (bf16_t*)(ws + FW_RA); b.N2b = (bf16_t*)(ws + FW_RE);
#if MK_PER_PHASE
  for (int ph = 0; ph < P_COUNT; ++ph) { a.ph_lo = ph; a.ph_hi = ph + 1; hipLaunchKernelGGL(mk_fwd, dim3(grid), dim3(NTHR), LDS_BYTES, stream, a, b); }
#else
  a.ph_lo = 0; a.ph_hi = P_COUNT;
  void* args[] = {&a, &b};
  hipError_t e = hipLaunchCooperativeKernel((const void*)mk_fwd, dim3(grid), dim3(NTHR), args, LDS_BYTES, stream);
  if (e != hipSuccess) fprintf(stderr, "kernel_launch: cooperative launch failed: %s (grid %d)\n", hipGetErrorString(e), grid);
#endif
}
```
